# Optimizing an MI355X kernel written in HIP

```python
import math
import jax
import jax.numpy as jnp
from jax import lax
import numpy as np

D_MODEL = 2048
BATCH = 1
SEQ = 16384
DEPTH = 2

GRID_W = 64
CTX_LEN = 256
Q_BLOCK = 128
ROPE_THETA = 10000.0
EPS = 1e-6
M_INIT = -1e30
N_EVEN = (DEPTH + 1) // 2
N_ODD = DEPTH // 2

A_HEAD_DIM = 128
A_HEADS = D_MODEL // (2 * A_HEAD_DIM)
A_KV_HEADS = A_HEADS // 4
A_GROUP = A_HEADS // A_KV_HEADS
B_QK_DIM = 128
B_V_DIM = 256
B_HEADS = D_MODEL // (2 * B_V_DIM)
MLSTM_CHUNK = 64
C_HEAD_DIM = A_HEAD_DIM
C_V_DIM = 2 * C_HEAD_DIM
C_HEADS = D_MODEL // C_V_DIM
FF_DENSE = ((8 * D_MODEL) // 3 + 255) // 256 * 256
N_EXPERTS = 8
TOP_K = 2
FF_EXPERT = 7 * D_MODEL // 2

A_Q = A_HEADS * A_HEAD_DIM
A_KV = A_KV_HEADS * A_HEAD_DIM
B_QK = B_HEADS * B_QK_DIM
B_V = B_HEADS * B_V_DIM
N_GATES = 4 * B_HEADS
EVEN_SIZES = (A_Q, A_KV, A_KV, B_QK, B_QK, B_V, B_V, N_GATES)
EVEN_IN = A_Q + 2 * A_KV + 2 * B_QK + 2 * B_V + N_GATES
EVEN_MIX = A_Q + B_V
C_QK = C_HEADS * 2 * C_HEAD_DIM
ODD_IN = 2 * C_QK + C_HEADS * C_V_DIM
ODD_MIX = C_HEADS * C_V_DIM
F32 = jnp.float32

kernel_name = 'hybrid_dit_gqa_mlstm_diffattn_moe'


def rms_norm(x, gain=None):
    xf = x.astype(F32)
    y = xf * lax.rsqrt(jnp.mean(xf * xf, axis=-1, keepdims=True) + EPS)
    if gain is not None:
        y = y * gain
    return y.astype(x.dtype)


def split_cols(a, sizes):
    offs, acc = [], 0
    for s in sizes[:-1]:
        acc += s
        offs.append(acc)
    return jnp.split(a, offs, axis=-1)


def axial_rope(rows, head_dim):
    row = jnp.broadcast_to(jnp.arange(rows)[:, None], (rows, GRID_W)).reshape(-1).astype(F32)
    col = jnp.broadcast_to(jnp.arange(GRID_W)[None, :], (rows, GRID_W)).reshape(-1).astype(F32)
    n_freq = head_dim // 4
    inv = ROPE_THETA ** (-jnp.arange(n_freq, dtype=F32) / n_freq)
    ang = jnp.concatenate([row[:, None] * inv, col[:, None] * inv], axis=-1)
    return jnp.cos(ang), jnp.sin(ang)


def apply_rope(x, cos, sin):
    xf = x.astype(F32).reshape(x.shape[:-1] + (x.shape[-1] // 2, 2))
    extra = (1,) * (x.ndim - 3)
    cos = cos.reshape(cos.shape[:1] + extra + cos.shape[1:])
    sin = sin.reshape(sin.shape[:1] + extra + sin.shape[1:])
    x0, x1 = xf[..., 0], xf[..., 1]
    out = jnp.stack([x0 * cos - x1 * sin, x0 * sin + x1 * cos], axis=-1)
    return out.reshape(x.shape).astype(x.dtype)


def sweep_query_blocks(fn, q):
    bsz, s = q.shape[:2]
    nb = s // Q_BLOCK
    qb = jnp.moveaxis(q.reshape((bsz, nb, Q_BLOCK) + q.shape[2:]), 1, 0)
    out = lax.map(fn, qb)
    return jnp.moveaxis(out, 0, 1).reshape((bsz, s) + out.shape[3:])


def gqa_attend(q, k, v):
    s = jnp.einsum('bqngd,bknd->bngqk', q, k).astype(F32) * (q.shape[-1] ** -0.5)
    p = jax.nn.softmax(s, axis=-1).astype(v.dtype)
    return jnp.einsum('bngqk,bknd->bqngd', p, v)


def diff_attend(q, k, v, lam):
    s = jnp.einsum('bqhrd,bkhrd->bhrqk', q, k).astype(F32) * (q.shape[-1] ** -0.5)
    p = jax.nn.softmax(s, axis=-1)
    a = (p[:, :, 0] - lam * p[:, :, 1]).astype(v.dtype)
    return jnp.einsum('bhqk,bkhe->bqhe', a, v)


def mlstm_chunkwise(q, k, v, ig, lf, state):
    bsz, nh, t, _ = q.shape
    dv = v.shape[-1]
    nc = t // MLSTM_CHUNK

    def chunks(a):
        a = a.astype(F32)
        return jnp.moveaxis(a.reshape(a.shape[:2] + (nc, MLSTM_CHUNK) + a.shape[3:]), 2, 0)

    xs = (chunks(q), chunks(k), chunks(v), chunks(ig), chunks(lf))
    lower = jnp.tril(jnp.ones((MLSTM_CHUNK, MLSTM_CHUNK), dtype=bool))

    def step(carry, inp):
        c_mem, n_mem, m = carry
        qc, kc, vc, ic, fc = inp
        bcum = jnp.cumsum(fc, axis=-1)
        dlog = jnp.where(lower, bcum[..., :, None] - bcum[..., None, :] + ic[..., None, :], -jnp.inf)
        inter = bcum + m[..., None]
        m_out = jnp.maximum(inter, jnp.max(dlog, axis=-1))
        w_intra = jnp.exp(dlog - m_out[..., None])
        w_inter = jnp.exp(inter - m_out)
        qk = jnp.einsum('bhjd,bhsd->bhjs', qc, kc) * w_intra
        num = w_inter[..., None] * jnp.einsum('bhjd,bhde->bhje', qc, c_mem) + jnp.einsum('bhjs,bhse->bhje', qk, vc)
        den = w_inter * jnp.einsum('bhjd,bhd->bhj', qc, n_mem) + jnp.sum(qk, axis=-1)
        h = num / jnp.maximum(jnp.abs(den), jnp.exp(-m_out))[..., None]
        b_last = bcum[..., -1]
        g = b_last[..., None] - bcum + ic
        m_new = jnp.maximum(b_last + m, jnp.max(g, axis=-1))
        a_dec = jnp.exp(b_last + m - m_new)
        w_in = jnp.exp(g - m_new[..., None])
        c_new = a_dec[..., None, None] * c_mem + jnp.einsum('bhs,bhsd,bhse->bhde', w_in, kc, vc)
        n_new = a_dec[..., None] * n_mem + jnp.einsum('bhs,bhsd->bhd', w_in, kc)
        return (c_new, n_new, m_new), h

    state, hs = lax.scan(step, state, xs)
    return state, jnp.moveaxis(hs, 0, 2).reshape(bsz, nh, t, dv)


def mlstm_direction(lat, ctx, reverse):
    if reverse:
        lat = tuple(jnp.flip(a, axis=2) for a in lat)
        ctx = tuple(jnp.flip(a, axis=2) for a in ctx)
    bsz, nh, _, dk = ctx[0].shape
    dv = ctx[2].shape[-1]
    state0 = (jnp.zeros((bsz, nh, dk, dv), F32), jnp.zeros((bsz, nh, dk), F32), jnp.full((bsz, nh), M_INIT, F32))
    state_ctx, h_c = mlstm_chunkwise(*ctx, state0)
    _, h_l = mlstm_chunkwise(*lat, state_ctx)
    if reverse:
        h_l, h_c = jnp.flip(h_l, axis=2), jnp.flip(h_c, axis=2)
    return h_l, h_c


def even_mixer(h_lat, h_ctx, w_in, gate_b, q_gain, k_gain, h_gain, w_out, cos, sin):
    def project(h, rope):
        bsz, t = h.shape[:2]
        qa, ka, va, qb, kb, vb, ob, gates = split_cols(h @ w_in, EVEN_SIZES)
        qa = rms_norm(qa.reshape(bsz, t, A_KV_HEADS, A_GROUP, A_HEAD_DIM), q_gain)
        ka = rms_norm(ka.reshape(bsz, t, A_KV_HEADS, A_HEAD_DIM), k_gain)
        va = va.reshape(bsz, t, A_KV_HEADS, A_HEAD_DIM)
        if rope:
            qa, ka = apply_rope(qa, cos, sin), apply_rope(ka, cos, sin)

        def heads(a, d):
            return jnp.swapaxes(a.reshape(bsz, t, B_HEADS, d), 1, 2)

        qb = heads(qb, B_QK_DIM) * (B_QK_DIM ** -0.5)
        kb, vb = heads(kb, B_QK_DIM), heads(vb, B_V_DIM)
        g = jnp.moveaxis((gates.astype(F32) + gate_b).reshape(bsz, t, 4, B_HEADS), 1, 3)
        fwd = (qb, kb, vb, g[:, 0], jax.nn.log_sigmoid(g[:, 1]))
        bwd = (qb, kb, vb, g[:, 2], jax.nn.log_sigmoid(g[:, 3]))
        return (qa, ka, va), fwd, bwd, ob.reshape(bsz, t, B_HEADS, B_V_DIM)

    att_l, fwd_l, bwd_l, o_l = project(h_lat, True)
    att_c, fwd_c, bwd_c, o_c = project(h_ctx, False)
    k_all = jnp.concatenate([att_l[1], att_c[1]], axis=1)
    v_all = jnp.concatenate([att_l[2], att_c[2]], axis=1)
    a_l = sweep_query_blocks(lambda qb: gqa_attend(qb, k_all, v_all), att_l[0])
    a_c = gqa_attend(*att_c)
    hf_l, hf_c = mlstm_direction(fwd_l, fwd_c, False)
    hb_l, hb_c = mlstm_direction(bwd_l, bwd_c, True)

    def merge(a, hf, hb, o):
        bsz, t = a.shape[:2]
        hm = rms_norm(jnp.swapaxes(hf + hb, 1, 2), h_gain) * jax.nn.sigmoid(o.astype(F32))
        mix = jnp.concatenate([a.reshape(bsz, t, A_Q), hm.reshape(bsz, t, B_V).astype(a.dtype)], axis=-1)
        return mix @ w_out

    return merge(a_l, hf_l, hb_l, o_l), merge(a_c, hf_c, hb_c, o_c)


def odd_mixer(h_lat, h_ctx, w_in, q_gain, k_gain, lam_q1, lam_k1, lam_q2, lam_k2, sub_gain, w_out,
              cos, sin, layer, update_ctx):
    lam_init = 0.8 - 0.6 * math.exp(-0.3 * layer)
    lam = (jnp.exp(jnp.sum(lam_q1 * lam_k1).astype(F32)) - jnp.exp(jnp.sum(lam_q2 * lam_k2).astype(F32))
           + lam_init)

    def qk_heads(a, gain):
        return rms_norm(a.reshape(a.shape[:2] + (C_HEADS, 2, C_HEAD_DIM)), gain)

    def v_heads(a):
        return a.reshape(a.shape[:2] + (C_HEADS, C_V_DIM))

    q_l, k_l, v_l = split_cols(h_lat @ w_in, (C_QK, C_QK, C_HEADS * C_V_DIM))
    q_l = apply_rope(qk_heads(q_l, q_gain), cos, sin)
    k_l = apply_rope(qk_heads(k_l, k_gain), cos, sin)
    v_l = v_heads(v_l)
    if update_ctx:
        q_c, k_c, v_c = split_cols(h_ctx @ w_in, (C_QK, C_QK, C_HEADS * C_V_DIM))
        q_c = qk_heads(q_c, q_gain)
    else:
        k_c, v_c = split_cols(h_ctx @ w_in[:, C_QK:], (C_QK, C_HEADS * C_V_DIM))
    k_c, v_c = qk_heads(k_c, k_gain), v_heads(v_c)
    k_all = jnp.concatenate([k_l, k_c], axis=1)
    v_all = jnp.concatenate([v_l, v_c], axis=1)

    def finish(o):
        o = rms_norm(o, sub_gain) * (1.0 - lam_init)
        return o.reshape(o.shape[:2] + (ODD_MIX,)) @ w_out

    y_l = finish(sweep_query_blocks(lambda qb: diff_attend(qb, k_all, v_all, lam), q_l))
    y_c = finish(diff_attend(q_c, k_c, v_c, lam)) if update_ctx else None
    return y_l, y_c


def swiglu(h, w_gate, w_up, w_down):
    return (jax.nn.silu(h @ w_gate) * (h @ w_up)) @ w_down


def moe_swiglu(h, router, w_gate, w_up, w_down):
    logits = (h @ router).astype(F32)
    top_v, top_i = lax.top_k(logits, TOP_K)
    top_w = jax.nn.softmax(top_v, axis=-1)
    gate = jnp.sum(jax.nn.one_hot(top_i, N_EXPERTS, dtype=F32) * top_w[..., None], axis=-2).astype(h.dtype)
    y = jnp.zeros(h.shape, h.dtype)
    for e in range(N_EXPERTS):
        y = y + gate[..., e:e + 1] * swiglu(h, w_gate[e], w_up[e], w_down[e])
    return y


def modulation(cvec, w, b):
    return jnp.split(jax.nn.silu(cvec) @ w + b, 6, axis=-1)


def setup_inputs(seed: int = 0) -> dict:
    key = jax.random.key(seed)
    ks = jax.random.split(key, 32)
    D = D_MODEL

    def nrm(k, shape, s):
        return jax.random.normal(k, shape, F32) * s

    gate_base = jnp.array([0.0, 3.0, 0.0, 3.0], F32)[None, :, None]
    return {
        'x': nrm(ks[0], (BATCH, SEQ, D), 1.0),
        'c': nrm(ks[1], (BATCH, D), 1.0),
        'ctx': nrm(ks[2], (BATCH, CTX_LEN, D), 1.0),
        'c_ctx': nrm(ks[3], (D,), 1.0),
        'ada_w': nrm(ks[4], (DEPTH, D, 6 * D), 0.5 * D ** -0.5),
        'ada_b': nrm(ks[5], (DEPTH, 6 * D), 0.01),
        'ev_w_in': nrm(ks[6], (N_EVEN, D, EVEN_IN), D ** -0.5),
        'ev_gate_b': (nrm(ks[7], (N_EVEN, 4, B_HEADS), 0.1) + gate_base).reshape(N_EVEN, N_GATES),
        'ev_q_gain': 1.0 + nrm(ks[8], (N_EVEN, A_HEAD_DIM), 0.02),
        'ev_k_gain': 1.0 + nrm(ks[9], (N_EVEN, A_HEAD_DIM), 0.02),
        'ev_h_gain': 1.0 + nrm(ks[10], (N_EVEN, B_HEADS, B_V_DIM), 0.02),
        'ev_w_out': nrm(ks[11], (N_EVEN, EVEN_MIX, D), EVEN_MIX ** -0.5),
        'ev_ff_gate': nrm(ks[12], (N_EVEN, D, FF_DENSE), D ** -0.5),
        'ev_ff_up': nrm(ks[13], (N_EVEN, D, FF_DENSE), D ** -0.5),
        'ev_ff_down': nrm(ks[14], (N_EVEN, FF_DENSE, D), FF_DENSE ** -0.5),
        'od_w_in': nrm(ks[15], (N_ODD, D, ODD_IN), D ** -0.5),
        'od_q_gain': 1.0 + nrm(ks[16], (N_ODD, C_HEAD_DIM), 0.02),
        'od_k_gain': 1.0 + nrm(ks[17], (N_ODD, C_HEAD_DIM), 0.02),
        'od_lam_q1': nrm(ks[18], (N_ODD, C_HEAD_DIM), 0.1),
        'od_lam_k1': nrm(ks[19], (N_ODD, C_HEAD_DIM), 0.1),
        'od_lam_q2': nrm(ks[20], (N_ODD, C_HEAD_DIM), 0.1),
        'od_lam_k2': nrm(ks[21], (N_ODD, C_HEAD_DIM), 0.1),
        'od_sub_gain': 1.0 + nrm(ks[22], (N_ODD, C_V_DIM), 0.02),
        'od_w_out': nrm(ks[23], (N_ODD, ODD_MIX, D), ODD_MIX ** -0.5),
        'od_router': nrm(ks[24], (N_ODD, D, N_EXPERTS), D ** -0.5),
        'od_ex_gate': nrm(ks[25], (N_ODD, N_EXPERTS, D, FF_EXPERT), D ** -0.5),
        'od_ex_up': nrm(ks[26], (N_ODD, N_EXPERTS, D, FF_EXPERT), D ** -0.5),
        'od_ex_down': nrm(ks[27], (N_ODD, N_EXPERTS, FF_EXPERT, D), FF_EXPERT ** -0.5),
    }


def reference(x, c, ctx, c_ctx, ada_w, ada_b,
              ev_w_in, ev_gate_b, ev_q_gain, ev_k_gain, ev_h_gain, ev_w_out,
              ev_ff_gate, ev_ff_up, ev_ff_down,
              od_w_in, od_q_gain, od_k_gain, od_lam_q1, od_lam_k1, od_lam_q2, od_lam_k2,
              od_sub_gain, od_w_out, od_router, od_ex_gate, od_ex_up, od_ex_down):
    rows = x.shape[1] // GRID_W
    cos, sin = axial_rope(rows, A_HEAD_DIM)
    x_lat, x_ctx = x, ctx
    for layer in range(DEPTH):
        update_ctx = layer < DEPTH - 1
        i = layer // 2
        m_lat = [m[:, None, :] for m in modulation(c, ada_w[layer], ada_b[layer])]
        m_ctx = modulation(c_ctx, ada_w[layer], ada_b[layer])
        h_lat = rms_norm(x_lat) * (1.0 + m_lat[1]) + m_lat[0]
        h_ctx = rms_norm(x_ctx) * (1.0 + m_ctx[1]) + m_ctx[0]
        if layer % 2 == 0:
            y_lat, y_ctx = even_mixer(h_lat, h_ctx, ev_w_in[i], ev_gate_b[i], ev_q_gain[i], ev_k_gain[i],
                                      ev_h_gain[i], ev_w_out[i], cos, sin)
            ffn = lambda h, i=i: swiglu(h, ev_ff_gate[i], ev_ff_up[i], ev_ff_down[i])
        else:
            y_lat, y_ctx = odd_mixer(h_lat, h_ctx, od_w_in[i], od_q_gain[i], od_k_gain[i], od_lam_q1[i],
                                     od_lam_k1[i], od_lam_q2[i], od_lam_k2[i], od_sub_gain[i], od_w_out[i],
                                     cos, sin, layer, update_ctx)
            ffn = lambda h, i=i: moe_swiglu(h, od_router[i], od_ex_gate[i], od_ex_up[i], od_ex_down[i])
        x_lat = x_lat + m_lat[2] * y_lat
        x_lat = x_lat + m_lat[5] * ffn(rms_norm(x_lat) * (1.0 + m_lat[4]) + m_lat[3])
        if update_ctx:
            x_ctx = x_ctx + m_ctx[2] * y_ctx
            x_ctx = x_ctx + m_ctx[5] * ffn(rms_norm(x_ctx) * (1.0 + m_ctx[4]) + m_ctx[3])
    return x_lat
```

```cpp
#include <hip/hip_runtime.h>
#include <cstdio>
#include <cstdint>
#ifndef MK_MULTI
#define MK_MULTI 0
#endif
namespace pg8 {
#define PG8_LAS __attribute__((address_space(3)))
typedef unsigned short bf16_t;
typedef short bf16x8 __attribute__((ext_vector_type(8)));
typedef float f32x4 __attribute__((ext_vector_type(4)));
typedef unsigned u32x4 __attribute__((ext_vector_type(4)));
constexpr int BM = 256, BK = 64, HALF = 128, HTB = HALF * BK * 2  , STAGE_BYTES = 8 * HTB, NXCD = 8, WGM = 8;

__host__ __device__ __forceinline__ int lds_byte(int r, int c) { const int st = (r >> 4) * 2 + (c >> 5), rr = r & 15, cc = c & 31, ob = rr * 64 + cc * 2; return st * 1024 + (ob ^ (((ob >> 9) & 1) << 5)); }
__host__ __device__ __forceinline__ void stage_rc(int b, int& R, int& C) { const int st = b / 1024, sb = b % 1024, swz = sb ^ (((sb >> 9) & 1) << 5); R = (st >> 1) * 16 + swz / 64; C = (st & 1) * 32 + (swz % 64) / 2; }
__host__ __device__ __forceinline__ int perm32(int rho) { const int n = rho >> 4, i = rho & 15; return 8 * (i >> 2) + 4 * n + (i & 3); }

struct Unit { int pm, pn, kt0, ntk; };
struct Gemm { const bf16_t* A; const bf16_t* Bt; int M, N, K; };

struct StaticOrder {
    int nM, nN, nwg, G, c;
    __host__ __device__ void init(int M, int N, int G_, int c_) { nM = M / BM; nN = N / BM; nwg = nM * nN; G = G_; c = c_; }
    __host__ __device__ bool next(int i, Unit& u) const {
        const long L = (long)i * G + c; if (L >= nwg) return false;
        int wgid = (int)L; { const int q = nwg / NXCD, r = nwg % NXCD, xcd = wgid % NXCD, off = wgid / NXCD; wgid = (xcd < r ? xcd * (q + 1) : r * (q + 1) + (xcd - r) * q) + off; }
        const int nig = WGM * nN, gid = wgid / nig, fm = gid * WGM, gsz = (nM - fm) < WGM ? (nM - fm) : WGM;
        u.pm = fm + ((wgid % nig) % gsz); u.pn = (wgid % nig) / gsz; return true;
    }
    __device__ __forceinline__ void a_ready(const Unit&) const {}
    __device__ __forceinline__ void done(const Unit&) const {}
};

typedef float f32x2c __attribute__((ext_vector_type(2)));
typedef __bf16 bf16x2c __attribute__((ext_vector_type(2)));
__device__ __forceinline__ unsigned cvt_pk_bf16(float lo, float hi) { const f32x2c v = {lo, hi}; const bf16x2c b = __builtin_convertvector(v, bf16x2c); return __builtin_bit_cast(unsigned, b); }
typedef float f32x2 __attribute__((ext_vector_type(2)));
__device__ __forceinline__ void static_map(int wgid, int nM, int nN, int& pm, int& pn) {
    const int nwg = nM * nN;
    { const int q = nwg / NXCD, r = nwg % NXCD, xcd = wgid % NXCD, off = wgid / NXCD; wgid = (xcd < r ? xcd * (q + 1) : r * (q + 1) + (xcd - r) * q) + off; }
    const int nig = WGM * nN, gid = wgid / nig, fm = gid * WGM, gsz = (nM - fm) < WGM ? (nM - fm) : WGM;
    pm = fm + ((wgid % nig) % gsz); pn = (wgid % nig) / gsz;
}
struct OdInOrder {
    int G, c;
    __device__ __forceinline__ bool next(int i, Unit& u) const {
        const int L = i * G + c;
        if (L < 64 * 24) { static_map(L, 64, 24, u.pm, u.pn); return true; }
        const int j = L - 64 * 24; if (j >= 16 * 8) return false;
        u.pm = 64; u.pn = 8 + (j >> 3); u.ntk = 4; u.kt0 = (j & 7) * 4; return true;
    }
    __device__ __forceinline__ void a_ready(const Unit&) const {}
    __device__ __forceinline__ void done(const Unit&) const {}
};
struct CtxSplitOrder {
    int G, c, nN, S, ntfull;
    __device__ __forceinline__ bool next(int i, Unit& u) const {
        const int L = i * G + c;
        if (L < 64 * nN) { static_map(L, 64, nN, u.pm, u.pn); return true; }
        const int j = L - 64 * nN; if (j >= nN * S) return false;
        u.pm = 64; u.pn = j / S; u.ntk = ntfull / S; u.kt0 = (j % S) * u.ntk; return true;
    }
    __device__ __forceinline__ void a_ready(const Unit&) const {}
    __device__ __forceinline__ void done(const Unit&) const {}
};
__device__ __forceinline__ void tail_split(int nM, int nN, int G, int ntfull, int& pm_split, int& S) {
    const int per = G / nN, rt = (per > 0 && G % nN == 0) ? nM % per : 0; pm_split = nM - rt; S = 1;
    if (rt > 0) { const int cap = G / (rt * nN);
        const int cand[6] = {28, 14, 8, 4, 2, 1};
#pragma unroll
        for (int q = 5; q >= 0; --q) if (cand[q] <= cap && ntfull % (2 * cand[q]) == 0 && ntfull / cand[q] >= 4) S = cand[q]; }
    if (S == 1) pm_split = nM;
}
struct GroupedOrder {
    int nM, nN, G, c; int t1, t2, t3, t4, t5, t6, t7; int pm_split, S, ntfull;
    __device__ __forceinline__ void init(const unsigned* cnt, int nN_, int G_, int c_, int ntfull_ = 0) {
        int t[9]; t[0] = 0;
#pragma unroll
        for (int e = 0; e < 8; ++e) t[e + 1] = t[e] + (int)((cnt[e] + 255u) >> 8);
        t1 = t[1]; t2 = t[2]; t3 = t[3]; t4 = t[4]; t5 = t[5]; t6 = t[6]; t7 = t[7]; nM = t[8]; nN = nN_; G = G_; c = c_; ntfull = ntfull_; pm_split = nM; S = 1;
        if (ntfull_ > 0) tail_split(nM, nN, G, ntfull_, pm_split, S);
    }
    __device__ __forceinline__ bool next(int i, Unit& u) const {
        const int L = i * G + c, nfull = pm_split * nN; int pm, j;
        if (L < nfull) static_map(L, pm_split, nN, pm, j);
        else { const int idx = L - nfull; if (idx >= (nM - pm_split) * nN * S) return false; const int q = idx / S; pm = pm_split + q / nN; j = q % nN; u.ntk = ntfull / S; u.kt0 = (idx % S) * u.ntk; }
        const int e = (pm >= t1) + (pm >= t2) + (pm >= t3) + (pm >= t4) + (pm >= t5) + (pm >= t6) + (pm >= t7);
        u.pm = pm; u.pn = e * nN + j; return true;
    }
    __device__ __forceinline__ void a_ready(const Unit&) const {}
    __device__ __forceinline__ void done(const Unit&) const {}
};

__device__ __forceinline__ float silu_f(float g) { return g * __builtin_amdgcn_rcpf(1.0f + __builtin_amdgcn_exp2f(-1.4426950408889634f * g)); }

template <int GATE_PN> struct EpiProj {
    static constexpr bool PERM = true, AFTER_DRAIN = false;
    bf16_t* O; int ldc; float* G; const float* gate_b;
    __device__ __forceinline__ void operator()(const f32x4 (&acc)[2][2][4][2], const Unit& u, int wr, int wc, int fr, int fq) const {
        const int row0 = u.pm * BM + wr * 64 + fr;
        if (GATE_PN >= 0 && u.pn == GATE_PN) {
            if (wc == 0 && fq < 2) {
#pragma unroll
                for (int ai = 0; ai < 2; ++ai)
#pragma unroll
                    for (int m = 0; m < 4; ++m) { float* gp = G + (size_t)(row0 + ai * HALF + m * 16) * 16 + 8 * fq;
#pragma unroll
                        for (int n = 0; n < 2; ++n) { const f32x4 b = *(const f32x4*)(gate_b + 8 * fq + 4 * n); *(f32x4*)(gp + 4 * n) = acc[ai][0][m][n] + b; } }
            }
            return;
        }
        const int col0 = u.pn * BM + wc * 32 + 8 * fq;
#pragma unroll
        for (int ai = 0; ai < 2; ++ai)
#pragma unroll
            for (int m = 0; m < 4; ++m) { bf16_t* rowp = O + (size_t)(row0 + ai * HALF + m * 16) * ldc + col0;
#pragma unroll
                for (int bj = 0; bj < 2; ++bj) { const f32x4 v0 = acc[ai][bj][m][0], v1 = acc[ai][bj][m][1];
                    u32x4 w; w.x = cvt_pk_bf16(v0[0], v0[1]); w.y = cvt_pk_bf16(v0[2], v0[3]); w.z = cvt_pk_bf16(v1[0], v1[1]); w.w = cvt_pk_bf16(v1[2], v1[3]);
                    *(u32x4*)(rowp + bj * HALF) = w; } }
    }
};
struct EpiProjSplit {
    static constexpr bool PERM = true, AFTER_DRAIN = false;
    bf16_t* O; int ldc; float* part; int ntfull;
    __device__ __forceinline__ void operator()(const f32x4 (&acc)[2][2][4][2], const Unit& u, int wr, int wc, int fr, int fq) const {
        const int col0 = u.pn * BM + wc * 32 + 8 * fq;
        if (u.ntk != ntfull) {
            float* pp = part + (size_t)(u.kt0 / u.ntk) * (256 * 4096) + (col0 - 2048);
#pragma unroll
            for (int ai = 0; ai < 2; ++ai)
#pragma unroll
                for (int m = 0; m < 4; ++m) { float* rowp = pp + (size_t)(wr * 64 + fr + ai * HALF + m * 16) * 4096;
#pragma unroll
                    for (int bj = 0; bj < 2; ++bj) { *(f32x4*)(rowp + bj * HALF) = acc[ai][bj][m][0]; *(f32x4*)(rowp + bj * HALF + 4) = acc[ai][bj][m][1]; } }
            return;
        }
        const int row0 = u.pm * BM + wr * 64 + fr;
#pragma unroll
        for (int ai = 0; ai < 2; ++ai)
#pragma unroll
            for (int m = 0; m < 4; ++m) { bf16_t* rowp = O + (size_t)(row0 + ai * HALF + m * 16) * ldc + col0;
#pragma unroll
                for (int bj = 0; bj < 2; ++bj) { const f32x4 v0 = acc[ai][bj][m][0], v1 = acc[ai][bj][m][1];
                    u32x4 w; w.x = cvt_pk_bf16(v0[0], v0[1]); w.y = cvt_pk_bf16(v0[2], v0[3]); w.z = cvt_pk_bf16(v1[0], v1[1]); w.w = cvt_pk_bf16(v1[2], v1[3]);
                    *(u32x4*)(rowp + bj * HALF) = w; } }
    }
};
struct EpiResid {
    static constexpr bool PERM = false, AFTER_DRAIN = false;
    const float* in_lat; float* out_lat; const float* g_lat; const float* in_ctx; float* out_ctx; const float* g_ctx; float* part; int ntfull;
    __device__ __forceinline__ void operator()(const f32x4 (&acc)[2][2][4][2], const Unit& u, int wr, int wc, int fr, int fq) const {
        const bool isc = u.pm >= 64; const int pml = isc ? u.pm - 64 : u.pm;
        const float* xin = isc ? in_ctx : in_lat; float* xout = isc ? out_ctx : out_lat; const float* gv = isc ? g_ctx : g_lat;
        const int row0 = pml * BM + wr * 64 + fr, col0 = u.pn * BM + wc * 32 + 4 * fq;
        f32x4 gg[2][2];
#pragma unroll
        for (int bj = 0; bj < 2; ++bj)
#pragma unroll
            for (int n = 0; n < 2; ++n) gg[bj][n] = *(const f32x4*)(gv + col0 + bj * HALF + n * 16);
        if (u.ntk != ntfull) {
            float* pp = part + (size_t)(u.kt0 / u.ntk) * (256 * 2048);
#pragma unroll
            for (int ai = 0; ai < 2; ++ai)
#pragma unroll
                for (int m = 0; m < 4; ++m) { const size_t off = (size_t)(row0 + ai * HALF + m * 16) * 2048 + col0;
#pragma unroll
                    for (int bj = 0; bj < 2; ++bj)
#pragma unroll
                        for (int n = 0; n < 2; ++n) *(f32x4*)(pp + off + bj * HALF + n * 16) = gg[bj][n] * acc[ai][bj][m][n]; }
            return;
        }
#pragma unroll
        for (int ai = 0; ai < 2; ++ai)
#pragma unroll
            for (int m = 0; m < 4; ++m) { const size_t off = (size_t)(row0 + ai * HALF + m * 16) * 2048 + col0;
#pragma unroll
                for (int bj = 0; bj < 2; ++bj)
#pragma unroll
                    for (int n = 0; n < 2; ++n) { const f32x4 xi = *(const f32x4*)(xin + off + bj * HALF + n * 16);
                        *(f32x4*)(xout + off + bj * HALF + n * 16) = xi + gg[bj][n] * acc[ai][bj][m][n]; } }
    }
};
__device__ __forceinline__ unsigned pk4_fp8(float a, float b, float c, float d) { unsigned w = (unsigned)__builtin_amdgcn_cvt_pk_fp8_f32(a, b, 0, false); return (unsigned)__builtin_amdgcn_cvt_pk_fp8_f32(c, d, (int)w, true); }
template <int NTN  , bool FP8OUT = false> struct EpiSwiGlu {
    static constexpr bool PERM = true, AFTER_DRAIN = false;
    bf16_t* O; int ldc; float isc;
    __device__ __forceinline__ void operator()(const f32x4 (&acc)[2][2][4][2], const Unit& u, int wr, int wc, int fr, int fq) const {
        const int pnl = u.pn % (NTN ? NTN : 0x7fffffff);
        const int row0 = u.pm * BM + wr * 64 + fr, hc0 = 128 * pnl + 32 * wc + 8 * fq;
#pragma unroll
        for (int ai = 0; ai < 2; ++ai)
#pragma unroll
            for (int m = 0; m < 4; ++m) {
                const f32x4 g0 = acc[ai][0][m][0] * isc, g1 = acc[ai][0][m][1] * isc, u0 = acc[ai][1][m][0] * isc, u1 = acc[ai][1][m][1] * isc;
                if constexpr (FP8OUT) { unsigned char* rowp = (unsigned char*)O + (size_t)(row0 + ai * HALF + m * 16) * ldc + hc0; typedef unsigned u32x2v __attribute__((ext_vector_type(2))); u32x2v w;
                    w.x = pk4_fp8(silu_f(g0[0]) * u0[0], silu_f(g0[1]) * u0[1], silu_f(g0[2]) * u0[2], silu_f(g0[3]) * u0[3]); w.y = pk4_fp8(silu_f(g1[0]) * u1[0], silu_f(g1[1]) * u1[1], silu_f(g1[2]) * u1[2], silu_f(g1[3]) * u1[3]);
                    *(u32x2v*)rowp = w; }
                else { bf16_t* rowp = O + (size_t)(row0 + ai * HALF + m * 16) * ldc + hc0;
                u32x4 w; w.x = cvt_pk_bf16(silu_f(g0[0]) * u0[0], silu_f(g0[1]) * u0[1]); w.y = cvt_pk_bf16(silu_f(g0[2]) * u0[2], silu_f(g0[3]) * u0[3]);
                w.z = cvt_pk_bf16(silu_f(g1[0]) * u1[0], silu_f(g1[1]) * u1[1]); w.w = cvt_pk_bf16(silu_f(g1[2]) * u1[2], silu_f(g1[3]) * u1[3]);
                *(u32x4*)rowp = w; } }
    }
};
struct EpiMoeDown {
    static constexpr bool PERM = true, AFTER_DRAIN = false;
    bf16_t* Y; float* slab; int pm_split, rt, ntfull; float osc;
    __device__ __forceinline__ void operator()(const f32x4 (&acc)[2][2][4][2], const Unit& u, int wr, int wc, int fr, int fq) const {
        const int col0 = (u.pn & 7) * BM + wc * 32 + 8 * fq;
        if (u.ntk != ntfull) {
            const int rl0 = (u.pm - pm_split) * BM + wr * 64 + fr; float* sp = slab + (size_t)(u.kt0 / u.ntk) * rt * 256 * 2048;
#pragma unroll
            for (int ai = 0; ai < 2; ++ai)
#pragma unroll
                for (int m = 0; m < 4; ++m) { float* rowp = sp + (size_t)(rl0 + ai * HALF + m * 16) * 2048 + col0;
#pragma unroll
                    for (int bj = 0; bj < 2; ++bj) { *(f32x4*)(rowp + bj * HALF) = acc[ai][bj][m][0] * osc; *(f32x4*)(rowp + bj * HALF + 4) = acc[ai][bj][m][1] * osc; } }
            return;
        }
        const int row0 = u.pm * BM + wr * 64 + fr;
#pragma unroll
        for (int ai = 0; ai < 2; ++ai)
#pragma unroll
            for (int m = 0; m < 4; ++m) { bf16_t* rowp = Y + (size_t)(row0 + ai * HALF + m * 16) * 2048 + col0;
#pragma unroll
                for (int bj = 0; bj < 2; ++bj) { const f32x4 v0 = acc[ai][bj][m][0] * osc, v1 = acc[ai][bj][m][1] * osc;
                    u32x4 w; w.x = cvt_pk_bf16(v0[0], v0[1]); w.y = cvt_pk_bf16(v0[2], v0[3]); w.z = cvt_pk_bf16(v1[0], v1[1]); w.w = cvt_pk_bf16(v1[2], v1[3]);
                    *(u32x4*)(rowp + bj * HALF) = w; } }
    }
};
template <class Epi, class Sched, bool ALIGN_EPI = false, bool SP2 = false, bool FP8 = false>
__device__ __forceinline__ void gemm_phase(PG8_LAS unsigned char* lds, const Gemm g, const Sched& S, const Epi& E) {
    const int tid = threadIdx.x, wid = __builtin_amdgcn_readfirstlane(tid >> 6), lane = tid & 63, wr = wid >> 2, wc = wid & 3, fr = lane & 15, fq = lane >> 4;
    const int K = g.K, nt = K / BK;
    unsigned voffA[2], voffB[2];
#pragma unroll
    for (int i = 0; i < 2; ++i) { int R, C; stage_rc(tid * 16 + i * 8192, R, C); const int Rb = Epi::PERM ? ((R & ~31) + perm32(R & 31)) : R;
        voffA[i] = (unsigned)(R * K + C) * 2u; voffB[i] = (unsigned)(Rb * K + C) * 2u; }
    const size_t kstep = (size_t)(BK * 2);
    const size_t hstep = (size_t)HALF * K * 2;
    const size_t tstep = 2 * hstep;
    const unsigned ldsw = (unsigned)wid * 1024u;
    const int aoff = lds_byte(wr * 64 + fr, fq * 8), boff = lds_byte(wc * 32 + fr, fq * 8);
#define PG8_SA(b, h) (((b) * 2 + (h)) * HTB)
#define PG8_SB(b, h) ((4 + (b) * 2 + (h)) * HTB)
#define PG8_STAGE(bufoff, gbase, voff) do { _Pragma("unroll") for (int _i = 0; _i < 2; ++_i) \
        __builtin_amdgcn_global_load_lds((const unsigned*)((const char*)(gbase) + (voff)[_i]), (PG8_LAS unsigned*)(lds + (bufoff) + ldsw + _i * 8192), 16, 0, 0); } while (0)
#define PG8_LDA(dst, b, h) do { _Pragma("unroll") for (int m = 0; m < 4; ++m) _Pragma("unroll") for (int k = 0; k < 2; ++k) dst[m][k] = *(const PG8_LAS bf16x8*)(lds + PG8_SA(b, h) + aoff + m * 2048 + k * 1024); } while (0)
#define PG8_LDB(dst, b, h) do { _Pragma("unroll") for (int n = 0; n < 2; ++n) _Pragma("unroll") for (int k = 0; k < 2; ++k) dst[n][k] = *(const PG8_LAS bf16x8*)(lds + PG8_SB(b, h) + boff + n * 2048 + k * 1024); } while (0)
    typedef int pg8_v8i __attribute__((ext_vector_type(8))); typedef int pg8_v4i __attribute__((ext_vector_type(4)));
#define PG8_CAT(x, y) __builtin_shufflevector(__builtin_bit_cast(pg8_v4i, x), __builtin_bit_cast(pg8_v4i, y), 0, 1, 2, 3, 4, 5, 6, 7)
#define PG8_MMA(ai, bj, At, Bt) do { __builtin_amdgcn_s_setprio(1); _Pragma("unroll") for (int m = 0; m < 4; ++m) _Pragma("unroll") for (int n = 0; n < 2; ++n) { \
        if constexpr (FP8) { const pg8_v8i a8_ = PG8_CAT(Bt[n][0], Bt[n][1]), b8_ = PG8_CAT(At[m][0], At[m][1]); asm volatile("v_mfma_f32_16x16x128_f8f6f4 %0, %1, %2, %0" : "+v"(acc[ai][bj][m][n]) : "v"(a8_), "v"(b8_)); } \
        else { _Pragma("unroll") for (int k = 0; k < 2; ++k) acc[ai][bj][m][n] = __builtin_amdgcn_mfma_f32_16x16x32_bf16(Bt[n][k], At[m][k], acc[ai][bj][m][n], 0, 0, 0); } } __builtin_amdgcn_s_setprio(0); } while (0)
#define PG8_WAIT_V(n) asm volatile("s_waitcnt vmcnt(" #n ")" ::: "memory")
#define PG8_WAIT_L(n) asm volatile("s_waitcnt lgkmcnt(" #n ")" ::: "memory")
#define PG8_BAR __builtin_amdgcn_s_barrier()
#define PG8_SCHED __builtin_amdgcn_sched_barrier(0)
    Unit cur, nxt; int ui = 0;
    cur.kt0 = 0; cur.ntk = nt; nxt.kt0 = 0; nxt.ntk = nt;
    if (!S.next(0, cur)) return;
    f32x4 acc[2][2][4][2];
#pragma unroll
    for (int a = 0; a < 2; ++a)
#pragma unroll
        for (int b = 0; b < 2; ++b)
#pragma unroll
            for (int m = 0; m < 4; ++m)
#pragma unroll
                for (int n = 0; n < 2; ++n) acc[a][b][m][n] = (f32x4){0.f, 0.f, 0.f, 0.f};
    bf16x8 At[4][2], B0[2][2], B1[2][2];
    const char* cA = (const char*)g.A + (size_t)cur.pm * tstep + (size_t)cur.kt0 * kstep; const char* cB = (const char*)g.Bt + (size_t)cur.pn * tstep + (size_t)cur.kt0 * kstep;
    S.a_ready(cur);
    if constexpr (SP2) {
        PG8_STAGE(PG8_SB(0, 0), cB, voffB); PG8_STAGE(PG8_SB(0, 1), cB + hstep, voffB); PG8_STAGE(PG8_SA(0, 0), cA, voffA); PG8_STAGE(PG8_SA(0, 1), cA + hstep, voffA);
        if (wr == 1) PG8_BAR;
        PG8_WAIT_V(2); PG8_BAR;
        PG8_STAGE(PG8_SB(1, 0), cB + kstep, voffB); PG8_STAGE(PG8_SA(1, 0), cA + kstep, voffA); PG8_STAGE(PG8_SB(1, 1), cB + hstep + kstep, voffB);
        PG8_WAIT_V(6); PG8_BAR;
    } else {
        PG8_STAGE(PG8_SB(0, 0), cB, voffB); PG8_STAGE(PG8_SA(0, 0), cA, voffA); PG8_STAGE(PG8_SB(0, 1), cB + hstep, voffB); PG8_STAGE(PG8_SA(0, 1), cA + hstep, voffA);
        if (wr == 1) PG8_BAR;
        PG8_WAIT_V(4); PG8_BAR;
        PG8_STAGE(PG8_SB(1, 0), cB + kstep, voffB); PG8_STAGE(PG8_SA(1, 0), cA + kstep, voffA); PG8_STAGE(PG8_SB(1, 1), cB + hstep + kstep, voffB);
        PG8_WAIT_V(6); PG8_BAR;
    }
    for (;;) {
        nxt.kt0 = 0; nxt.ntk = nt;
        const bool has_next = S.next(ui + 1, nxt);
        const char* nA = has_next ? (const char*)g.A + (size_t)nxt.pm * tstep + (size_t)nxt.kt0 * kstep : cA; const char* nB = has_next ? (const char*)g.Bt + (size_t)nxt.pn * tstep + (size_t)nxt.kt0 * kstep : cB;
        const int cnt_ = cur.ntk;
        for (int t = 0; t < cnt_; t += 2) {
            const bool last = (t == cnt_ - 2);
            const char* a1 = cA + (size_t)(t + 1) * kstep;
            const char* a2 = last ? nA : cA + (size_t)(t + 2) * kstep; const char* b2 = last ? nB : cB + (size_t)(t + 2) * kstep;
            const char* a3 = a2 + kstep; const char* b3 = b2 + kstep;
            if (last && has_next) S.a_ready(nxt);
            if constexpr (SP2) {
            PG8_LDB(B0, 0, 0); PG8_LDB(B1, 0, 1); PG8_SCHED; PG8_LDA(At, 0, 0); PG8_STAGE(PG8_SA(1, 1), a1 + hstep, voffA);
            PG8_WAIT_V(8); PG8_WAIT_L(0); PG8_BAR; PG8_MMA(0, 0, At, B0); PG8_MMA(0, 1, At, B1); PG8_BAR; PG8_SCHED;
            PG8_LDA(At, 0, 1); PG8_STAGE(PG8_SB(0, 0), b2, voffB); PG8_STAGE(PG8_SB(0, 1), b2 + hstep, voffB); PG8_STAGE(PG8_SA(0, 0), a2, voffA);
            PG8_WAIT_V(8); PG8_WAIT_L(0); PG8_BAR; PG8_MMA(1, 0, At, B0); PG8_MMA(1, 1, At, B1); PG8_BAR; PG8_SCHED;
            PG8_LDB(B0, 1, 0); PG8_LDB(B1, 1, 1); PG8_SCHED; PG8_LDA(At, 1, 0); PG8_STAGE(PG8_SA(0, 1), a2 + hstep, voffA);
            PG8_WAIT_V(8); PG8_WAIT_L(0); PG8_BAR; PG8_MMA(0, 0, At, B0); PG8_MMA(0, 1, At, B1); PG8_BAR; PG8_SCHED;
            PG8_LDA(At, 1, 1); PG8_STAGE(PG8_SB(1, 0), b3, voffB); PG8_STAGE(PG8_SB(1, 1), b3 + hstep, voffB); PG8_STAGE(PG8_SA(1, 0), a3, voffA);
            PG8_WAIT_V(8); PG8_WAIT_L(0); PG8_BAR; PG8_MMA(1, 0, At, B0); PG8_MMA(1, 1, At, B1); PG8_BAR; PG8_SCHED;
            } else {
            PG8_LDB(B0, 0, 0); PG8_SCHED; PG8_LDA(At, 0, 0); PG8_STAGE(PG8_SA(1, 1), a1 + hstep, voffA);
            PG8_WAIT_L(8); PG8_BAR; PG8_WAIT_L(0); PG8_MMA(0, 0, At, B0); PG8_BAR; PG8_SCHED;
            PG8_LDB(B1, 0, 1); PG8_STAGE(PG8_SB(0, 0), b2, voffB);
            PG8_BAR; PG8_WAIT_L(0); PG8_MMA(0, 1, At, B1); PG8_BAR;
            PG8_LDA(At, 0, 1); PG8_STAGE(PG8_SA(0, 0), a2, voffA);
            PG8_BAR; PG8_WAIT_L(0); PG8_MMA(1, 0, At, B0); PG8_BAR; PG8_SCHED;
            PG8_STAGE(PG8_SB(0, 1), b2 + hstep, voffB);
            PG8_WAIT_V(6); PG8_BAR; PG8_MMA(1, 1, At, B1); PG8_BAR;
            PG8_LDB(B0, 1, 0); PG8_SCHED; PG8_LDA(At, 1, 0); PG8_STAGE(PG8_SA(0, 1), a2 + hstep, voffA);
            PG8_WAIT_L(8); PG8_BAR; PG8_WAIT_L(0); PG8_MMA(0, 0, At, B0); PG8_BAR; PG8_SCHED;
            PG8_LDB(B1, 1, 1); PG8_STAGE(PG8_SB(1, 0), b3, voffB);
            PG8_BAR; PG8_WAIT_L(0); PG8_MMA(0, 1, At, B1); PG8_BAR;
            PG8_LDA(At, 1, 1); PG8_STAGE(PG8_SA(1, 0), a3, voffA);
            PG8_BAR; PG8_WAIT_L(0); PG8_MMA(1, 0, At, B0); PG8_BAR; PG8_SCHED;
            PG8_STAGE(PG8_SB(1, 1), b3 + hstep, voffB);
            PG8_WAIT_V(6); PG8_BAR; PG8_MMA(1, 1, At, B1); PG8_BAR;
            }
        }
        if constexpr (ALIGN_EPI) { if (wr == 0) PG8_BAR; }
        if constexpr (!Epi::AFTER_DRAIN) { E(acc, cur, wr, wc, fr, fq); S.done(cur); }
        if (!has_next) break;
#pragma unroll
        for (int a = 0; a < 2; ++a)
#pragma unroll
            for (int b = 0; b < 2; ++b)
#pragma unroll
                for (int m = 0; m < 4; ++m)
#pragma unroll
                    for (int n = 0; n < 2; ++n) acc[a][b][m][n] = (f32x4){0.f, 0.f, 0.f, 0.f};
        cur = nxt; cA = nA; cB = nB; ++ui;
        if constexpr (ALIGN_EPI) { if (wr == 1) PG8_BAR; }
    }
    PG8_WAIT_V(0);
    if constexpr (!ALIGN_EPI) { if (wr == 0) PG8_BAR; }
    PG8_BAR;
    if constexpr (Epi::AFTER_DRAIN) { E.fused(acc, cur, wr, wc, fr, fq, lds, wid, lane); S.done(cur); }
#undef PG8_SA
#undef PG8_SB
#undef PG8_STAGE
#undef PG8_LDA
#undef PG8_LDB
#undef PG8_MMA
#undef PG8_CAT
#undef PG8_WAIT_V
#undef PG8_WAIT_L
#undef PG8_BAR
#undef PG8_SCHED
}
}

namespace att {
typedef unsigned short bf16;
constexpr int   D = 128, NW = 8, QBLK = 32, KVBLK = 64;
constexpr float SCALE = 0.088388347648318440f;
constexpr float THR = 8.f;
constexpr int SDEPTH = 2;
constexpr size_t SHM_V = KVBLK * D * 2, SHM_K = KVBLK * 272, SHM_ATTN = 2 * SHM_V + 2 * SHM_K + NW * 64 * 4;
using bf16x8 = __attribute__((ext_vector_type(8))) short;
using s16x4  = __attribute__((ext_vector_type(4))) short;
using f32x16 = __attribute__((ext_vector_type(16))) float;
using f32x8  = __attribute__((ext_vector_type(8))) float;
using u32x4  = __attribute__((ext_vector_type(4))) unsigned;
#define KSWZ(row, colB) ((row) * 272 + (colB))
#define SBAR() __builtin_amdgcn_sched_barrier(0)
__device__ __forceinline__ int crow(int r, int hi) { return (r & 3) + 8 * (r >> 2) + 4 * hi; }
__device__ __forceinline__ unsigned cvtpk(float lo, float hi) {
  unsigned r; asm volatile("v_cvt_pk_bf16_f32 %0, %1, %2" : "=v"(r) : "v"(lo), "v"(hi)); return r;
}
struct StageB { using T = bf16x8;
  __device__ static __forceinline__ T ld8(const bf16* p) { return *reinterpret_cast<const bf16x8*>(p); }
  __device__ static __forceinline__ bf16x8 tobf(T x) { return x; } };
__device__ __forceinline__ void partialSM(bool fixm, f32x16& p0, f32x16& p1, float& m_reg, float& mn, float& alpha) {
  constexpr float C = SCALE * 1.4426950408889634f;
  if (fixm) {
    mn = m_reg; alpha = 1.f;
  } else {
  float pmax = p0[0]; for (int r = 1; r < 16; ++r) pmax = fmaxf(pmax, p0[r]); for (int r = 0; r < 16; ++r) pmax = fmaxf(pmax, p1[r]);
  { auto rr = __builtin_amdgcn_permlane32_swap(__float_as_uint(pmax), __float_as_uint(pmax), false, false);
    pmax = fmaxf(__uint_as_float(rr[0]), __uint_as_float(rr[1])); }
  if (__builtin_expect(__all(pmax - m_reg <= THR / SCALE), 1)) { mn = m_reg; alpha = 1.f; }
  else { mn = fmaxf(m_reg, pmax); alpha = __builtin_amdgcn_exp2f((m_reg - mn) * C); m_reg = mn; }
  }
  float mnC = -mn * C;
  for (int r = 0; r < 16; ++r) p0[r] = fmaf(p0[r], C, mnC); for (int r = 0; r < 16; ++r) p1[r] = fmaf(p1[r], C, mnC);
  for (int r = 0; r < 16; ++r) p0[r] = __builtin_amdgcn_exp2f(p0[r]);
}
__device__ __forceinline__ void finishSM(f32x16& p0, f32x16& p1, float alpha, float& l_reg, bf16x8& pa0, bf16x8& pa1, bf16x8& pa2, bf16x8& pa3) {
  for (int r = 0; r < 16; ++r) p1[r] = __builtin_amdgcn_exp2f(p1[r]);
  float ps = 0; for (int r = 0; r < 16; ++r) ps += p0[r]; for (int r = 0; r < 16; ++r) ps += p1[r];
  { auto rr = __builtin_amdgcn_permlane32_swap(__float_as_uint(ps), __float_as_uint(ps), false, false);
    ps = __uint_as_float(rr[0]) + __uint_as_float(rr[1]); }
  l_reg = l_reg * alpha + ps;
#define PK4(P, BASE, OUT) do { unsigned a0 = cvtpk(P[BASE + 0], P[BASE + 1]), a1 = cvtpk(P[BASE + 2], P[BASE + 3]);   \
    unsigned b0 = cvtpk(P[BASE + 4], P[BASE + 5]), b1 = cvtpk(P[BASE + 6], P[BASE + 7]);                              \
    auto r0 = __builtin_amdgcn_permlane32_swap(a0, b0, false, false); auto r1 = __builtin_amdgcn_permlane32_swap(a1, b1, false, false); \
    u32x4 w = {r0[0], r1[0], r0[1], r1[1]}; OUT = *reinterpret_cast<bf16x8*>(&w); } while (0)
  PK4(p0, 0, pa0); PK4(p0, 8, pa1); PK4(p1, 0, pa2); PK4(p1, 8, pa3);
#undef PK4
}
__device__ __forceinline__ void finishSM_noexp(f32x16& p0, f32x16& p1, float& l_reg, bf16x8& pa0, bf16x8& pa1, bf16x8& pa2, bf16x8& pa3) {
  float ps = 0; for (int r = 0; r < 16; ++r) ps += p0[r]; for (int r = 0; r < 16; ++r) ps += p1[r];
  { auto rr = __builtin_amdgcn_permlane32_swap(__float_as_uint(ps), __float_as_uint(ps), false, false);
    ps = __uint_as_float(rr[0]) + __uint_as_float(rr[1]); }
  l_reg += ps;
#define PK4(P, BASE, OUT) do { unsigned a0 = cvtpk(P[BASE + 0], P[BASE + 1]), a1 = cvtpk(P[BASE + 2], P[BASE + 3]);   \
    unsigned b0 = cvtpk(P[BASE + 4], P[BASE + 5]), b1 = cvtpk(P[BASE + 6], P[BASE + 7]);                              \
    auto r0 = __builtin_amdgcn_permlane32_swap(a0, b0, false, false); auto r1 = __builtin_amdgcn_permlane32_swap(a1, b1, false, false); \
    u32x4 w = {r0[0], r1[0], r0[1], r1[1]}; OUT = *reinterpret_cast<bf16x8*>(&w); } while (0)
  PK4(p0, 0, pa0); PK4(p0, 8, pa1); PK4(p1, 0, pa2); PK4(p1, 8, pa3);
#undef PK4
}
__device__ __forceinline__ void qkt(f32x16& p0, f32x16& p1, const bf16* Ks, const bf16x8* qr, int r32, int hi) {
  p0 = f32x16{}; p1 = f32x16{};
  for (int d0 = 0; d0 < 8; ++d0) { int cb = (d0 * 16 + hi * 8) * 2;
    bf16x8 b0 = *reinterpret_cast<const bf16x8*>((const char*)Ks + KSWZ(r32, cb));
    bf16x8 b1 = *reinterpret_cast<const bf16x8*>((const char*)Ks + KSWZ(32 + r32, cb));
    p0 = __builtin_amdgcn_mfma_f32_32x32x16_bf16(b0, qr[d0], p0, 0, 0, 0);
    p1 = __builtin_amdgcn_mfma_f32_32x32x16_bf16(b1, qr[d0], p1, 0, 0, 0); }
}
__device__ __forceinline__ void qkt_lean(f32x16& p0, f32x16& p1, const bf16* Ks, const bf16x8* qr, int r32, int hi) {
  p0 = f32x16{}; p1 = f32x16{};
#pragma unroll
  for (int d0 = 0; d0 < 8; ++d0) { int cb = (d0 * 16 + hi * 8) * 2;
    bf16x8 b0 = *reinterpret_cast<const bf16x8*>((const char*)Ks + KSWZ(r32, cb));
    bf16x8 b1 = *reinterpret_cast<const bf16x8*>((const char*)Ks + KSWZ(32 + r32, cb));
    p0 = __builtin_amdgcn_mfma_f32_32x32x16_bf16(b0, qr[d0], p0, 0, 0, 0);
    p1 = __builtin_amdgcn_mfma_f32_32x32x16_bf16(b1, qr[d0], p1, 0, 0, 0);
    if (d0 & 1) SBAR(); }
}
__device__ __forceinline__ int v_st(int k, int c) { const int kk = (k & ~0xC) | ((k & 4) << 1) | ((k & 8) >> 1); return ((kk >> 3) * 4 + (c >> 5)) * 512 + ((kk & 7) * 32 + (c & 31)) * 2; }
__device__ __forceinline__ int v_rd_base(int lane) { return ((lane & 3) << 3) | (((lane >> 2) & 3) << 6) | (((lane >> 4) & 1) << 5) | (((lane >> 5) & 1) << 8); }
constexpr int v_rd_off(int d0, int ks, int half) { return d0 * 512 + ks * 4096 + half * 2048; }
template <int OFF> __device__ __forceinline__ s16x4 tr_read(int vb) {
  s16x4 r; asm volatile("ds_read_b64_tr_b16 %0, %1 offset:%2" : "=&v"(r) : "v"(vb), "i"(OFF) : "memory"); return r;
}
template <int D0> __device__ __forceinline__ void pv_one(f32x16& od, int vb, bf16x8 pa0, bf16x8 pa1, bf16x8 pa2, bf16x8 pa3) {
  const s16x4 l0 = tr_read<v_rd_off(D0, 0, 0)>(vb), h0 = tr_read<v_rd_off(D0, 0, 1)>(vb), l1 = tr_read<v_rd_off(D0, 1, 0)>(vb), h1 = tr_read<v_rd_off(D0, 1, 1)>(vb);
  const s16x4 l2 = tr_read<v_rd_off(D0, 2, 0)>(vb), h2 = tr_read<v_rd_off(D0, 2, 1)>(vb), l3 = tr_read<v_rd_off(D0, 3, 0)>(vb), h3 = tr_read<v_rd_off(D0, 3, 1)>(vb);
  asm volatile("s_waitcnt lgkmcnt(0)" ::: "memory"); SBAR();
#define PK(L, H) (bf16x8){L[0], L[1], L[2], L[3], H[0], H[1], H[2], H[3]}
  od = __builtin_amdgcn_mfma_f32_32x32x16_bf16(pa0, PK(l0, h0), od, 0, 0, 0);
  od = __builtin_amdgcn_mfma_f32_32x32x16_bf16(pa1, PK(l1, h1), od, 0, 0, 0);
  od = __builtin_amdgcn_mfma_f32_32x32x16_bf16(pa2, PK(l2, h2), od, 0, 0, 0);
  od = __builtin_amdgcn_mfma_f32_32x32x16_bf16(pa3, PK(l3, h3), od, 0, 0, 0);
#undef PK
}
template <int D0> __device__ __forceinline__ void pv_two(f32x16& oa, f32x16& ob, int vb, bf16x8 pa0, bf16x8 pa1, bf16x8 pa2, bf16x8 pa3) {
  const s16x4 l0 = tr_read<v_rd_off(D0, 0, 0)>(vb), h0 = tr_read<v_rd_off(D0, 0, 1)>(vb), l1 = tr_read<v_rd_off(D0, 1, 0)>(vb), h1 = tr_read<v_rd_off(D0, 1, 1)>(vb);
  const s16x4 l2 = tr_read<v_rd_off(D0, 2, 0)>(vb), h2 = tr_read<v_rd_off(D0, 2, 1)>(vb), l3 = tr_read<v_rd_off(D0, 3, 0)>(vb), h3 = tr_read<v_rd_off(D0, 3, 1)>(vb);
  const s16x4 m0 = tr_read<v_rd_off(D0 + 1, 0, 0)>(vb), g0 = tr_read<v_rd_off(D0 + 1, 0, 1)>(vb), m1 = tr_read<v_rd_off(D0 + 1, 1, 0)>(vb), g1 = tr_read<v_rd_off(D0 + 1, 1, 1)>(vb);
  const s16x4 m2 = tr_read<v_rd_off(D0 + 1, 2, 0)>(vb), g2 = tr_read<v_rd_off(D0 + 1, 2, 1)>(vb), m3 = tr_read<v_rd_off(D0 + 1, 3, 0)>(vb), g3 = tr_read<v_rd_off(D0 + 1, 3, 1)>(vb);
  asm volatile("s_waitcnt lgkmcnt(8)" ::: "memory"); SBAR();
#define PK(L, H) (bf16x8){L[0], L[1], L[2], L[3], H[0], H[1], H[2], H[3]}
  oa = __builtin_amdgcn_mfma_f32_32x32x16_bf16(pa0, PK(l0, h0), oa, 0, 0, 0);
  oa = __builtin_amdgcn_mfma_f32_32x32x16_bf16(pa1, PK(l1, h1), oa, 0, 0, 0);
  oa = __builtin_amdgcn_mfma_f32_32x32x16_bf16(pa2, PK(l2, h2), oa, 0, 0, 0);
  oa = __builtin_amdgcn_mfma_f32_32x32x16_bf16(pa3, PK(l3, h3), oa, 0, 0, 0);
  asm volatile("s_waitcnt lgkmcnt(0)" ::: "memory"); SBAR();
  ob = __builtin_amdgcn_mfma_f32_32x32x16_bf16(pa0, PK(m0, g0), ob, 0, 0, 0);
  ob = __builtin_amdgcn_mfma_f32_32x32x16_bf16(pa1, PK(m1, g1), ob, 0, 0, 0);
  ob = __builtin_amdgcn_mfma_f32_32x32x16_bf16(pa2, PK(m2, g2), ob, 0, 0, 0);
  ob = __builtin_amdgcn_mfma_f32_32x32x16_bf16(pa3, PK(m3, g3), ob, 0, 0, 0);
#undef PK
}
__device__ __forceinline__ void pv_d0(f32x16* o, int vb, bf16x8 pa0, bf16x8 pa1, bf16x8 pa2, bf16x8 pa3) {
  pv_one<0>(o[0], vb, pa0, pa1, pa2, pa3); pv_one<1>(o[1], vb, pa0, pa1, pa2, pa3); pv_one<2>(o[2], vb, pa0, pa1, pa2, pa3); pv_one<3>(o[3], vb, pa0, pa1, pa2, pa3);
}

template <int LDQ, int LDK, int LDO, bool OBF, int SD>
__device__ __forceinline__ void attn_dense_body(const bf16* __restrict__ Qb, const bf16* __restrict__ Kh, const bf16* __restrict__ Vh,
                                                void* __restrict__ Obv, int seq, char* lds, bool fixm, float mref) {
  using St = StageB; using SQ = StageB;
#define QKT(a, b, c, d, e, f) do { if constexpr (SD == 1) qkt_lean(a, b, c, d, e, f); else qkt(a, b, c, d, e, f); } while (0)
  const int tid = threadIdx.x, wid = tid >> 6, lane = tid & 63, r32 = lane & 31, hi = lane >> 5;
  bf16* V_lds = (bf16*)lds; bf16* K_lds = (bf16*)(lds + 2 * SHM_V);
  float* ws = (float*)(lds + 2 * SHM_V + 2 * SHM_K) + wid * 64; float* li_l = ws; float* al_l = ws + 32;
  float m_reg = fixm ? mref : -1e30f, l_reg = 0; f32x16 o[4] = {}; bf16x8 qr[8];
  const bf16* Qw = Qb + (long)(wid * QBLK + r32) * LDQ + hi * 8;
#pragma unroll
  for (int d0 = 0; d0 < 8; ++d0) qr[d0] = SQ::tobf(SQ::ld8(Qw + d0 * 16));
  const int sr = tid >> 4, sc = (tid & 15) * 8, vst0 = v_st(sr, sc), vst1 = v_st(32 + sr, sc);
  const int vb0 = (int)(uintptr_t)V_lds + v_rd_base(lane);
  struct { typename St::T vs0, vs1, ks0, ks1; } sr_[SD];
  const unsigned voff0 = (unsigned)(sr * LDK + sc) * 2u, voff1 = voff0 + 32u * LDK * 2u;
#define SLOAD(i, k0) do { const char* vb_ = (const char*)Vh + (size_t)(k0) * (LDK * 2); const char* kb_ = (const char*)Kh + (size_t)(k0) * (LDK * 2); \
    sr_[i].vs0 = *(const bf16x8*)(vb_ + voff0); sr_[i].vs1 = *(const bf16x8*)(vb_ + voff1); sr_[i].ks0 = *(const bf16x8*)(kb_ + voff0); sr_[i].ks1 = *(const bf16x8*)(kb_ + voff1); } while (0)
#define SWRITE(b, i) do { *(bf16x8*)((char*)V_lds + (b) * SHM_V + vst0) = St::tobf(sr_[i].vs0);          \
    *(bf16x8*)((char*)V_lds + (b) * SHM_V + vst1) = St::tobf(sr_[i].vs1); int kc = sc * 2;               \
    *(bf16x8*)((char*)K_lds + (b) * SHM_K + KSWZ(sr, kc)) = St::tobf(sr_[i].ks0);                       \
    *(bf16x8*)((char*)K_lds + (b) * SHM_K + KSWZ(32 + sr, kc)) = St::tobf(sr_[i].ks1); } while (0)
#define SWAIT() do { if constexpr (SD == 2) asm volatile("s_waitcnt vmcnt(4)" ::: "memory"); else asm volatile("s_waitcnt vmcnt(0)" ::: "memory"); } while (0)
#define RESC(a) do { if (!fixm && __any((a) < 1.f)) { if (hi == 0) al_l[r32] = (a); asm volatile("s_waitcnt lgkmcnt(0)" ::: "memory"); \
    for (int d = 0; d < 4; ++d) for (int r = 0; r < 16; ++r) o[d][r] *= al_l[crow(r, hi)]; } } while (0)
  f32x16 pA0, pA1, pB0, pB1; float mnA, mnB, alA, alB; bf16x8 pa0, pa1, pa2, pa3; const int NT = seq / KVBLK;
  constexpr int SE = 0, SO = SD - 1;
  SLOAD(SE, 0); asm volatile("s_waitcnt vmcnt(0)" ::: "memory"); SWRITE(0, SE); __syncthreads();
  QKT(pA0, pA1, K_lds, qr, r32, hi); partialSM(fixm, pA0, pA1, m_reg, mnA, alA);
  SLOAD(SO, KVBLK); if constexpr (SD == 2) { if (2 < NT) SLOAD(SE, 2 * KVBLK); }
  SWAIT(); SWRITE(1, SO); __syncthreads();
  for (int j = 1; j + 1 < NT; j += 2) {
    SBAR(); QKT(pB0, pB1, (bf16*)((char*)K_lds + SHM_K), qr, r32, hi);
    finishSM(pA0, pA1, alA, l_reg, pa0, pa1, pa2, pa3); SBAR();
    SLOAD(SO, (j + SD) * KVBLK); SBAR();
    pv_d0(o, vb0, pa0, pa1, pa2, pa3); partialSM(fixm, pB0, pB1, m_reg, mnB, alB);
    __syncthreads(); SWAIT(); SWRITE(0, SE);
    RESC(alB); __syncthreads();
    SBAR(); QKT(pA0, pA1, K_lds, qr, r32, hi);
    finishSM(pB0, pB1, alB, l_reg, pa0, pa1, pa2, pa3); SBAR();
    if (SD == 1 || j + 3 < NT) SLOAD(SE, (j + 1 + SD) * KVBLK); SBAR();
    pv_d0(o, vb0 + (int)SHM_V, pa0, pa1, pa2, pa3); partialSM(fixm, pA0, pA1, m_reg, mnA, alA);
    __syncthreads(); SWAIT(); SWRITE(1, SO);
    RESC(alA); __syncthreads();
  }
  SBAR(); QKT(pB0, pB1, (bf16*)((char*)K_lds + SHM_K), qr, r32, hi);
  finishSM(pA0, pA1, alA, l_reg, pa0, pa1, pa2, pa3); SBAR();
  pv_d0(o, vb0, pa0, pa1, pa2, pa3); partialSM(fixm, pB0, pB1, m_reg, mnB, alB);
  __syncthreads(); RESC(alB);
  finishSM(pB0, pB1, alB, l_reg, pa0, pa1, pa2, pa3); SBAR();
  pv_d0(o, vb0 + (int)SHM_V, pa0, pa1, pa2, pa3);
  { int r32e = r32; asm volatile("" : "+v"(r32e)); if (hi == 0) li_l[r32e] = l_reg; } asm volatile("s_waitcnt lgkmcnt(0)" ::: "memory");
  int r32e = r32, hie = hi; asm volatile("" : "+v"(r32e), "+v"(hie));
  float rli[16];
#pragma unroll
  for (int r = 0; r < 16; ++r) rli[r] = __builtin_amdgcn_rcpf(li_l[crow(r, hie)]);
  if constexpr (OBF) {
    bf16* Ow = (bf16*)Obv + (long)(wid * QBLK + 4 * hie) * LDO + r32e;
#pragma unroll
    for (int r = 0; r < 16; ++r) { const int orow = (r & 3) + 8 * (r >> 2);
      for (int d0 = 0; d0 < 4; ++d0) { const float v = o[d0][r] * rli[r]; unsigned u = __float_as_uint(v); u = (u + 0x7fffu + ((u >> 16) & 1u)) >> 16; Ow[(long)orow * LDO + d0 * 32] = (bf16)u; } }
  } else {
    float* rowp = (float*)Obv + (long)(wid * QBLK + 4 * hie) * LDO + r32e;
#pragma unroll
    for (int g = 0; g < 4; ++g) { float* pg = rowp + (long)(8 * g) * LDO; asm volatile("" : "+v"(pg));
#pragma unroll
      for (int i = 0; i < 4; ++i)
#pragma unroll
        for (int d0 = 0; d0 < 4; ++d0) pg[(long)i * LDO + d0 * 32] = o[d0][4 * g + i] * rli[4 * g + i]; }
  }
#undef SLOAD
#undef QKT
#undef SWRITE
#undef SWAIT
#undef RESC
}

constexpr size_t PB_V = 32768, PB_K = KVBLK * 272, PB_P = 4096;
constexpr size_t PB_OFF_K = 2 * PB_V, PB_OFF_P = PB_OFF_K + 2 * PB_K, PB_OFF_L = PB_OFF_P + 8 * PB_P, SHM_PAIR = PB_OFF_L + 2 * 8 * 32 * 4;
template <int LDQ, int LDK, int LDV, int LDO>
__device__ __forceinline__ void attn_pair_body(const bf16* __restrict__ Qb, const bf16* __restrict__ Kh, const bf16* __restrict__ Vh, float* __restrict__ Ob, int seq, char* lds, float mref) {
  const int tid = threadIdx.x, wid = tid >> 6, lane = tid & 63, r32 = lane & 31, hi = lane >> 5, rb = wid & 3, ch = wid >> 2;
  char* V_lds = lds; char* K_lds = lds + PB_OFF_K; char* P_lds = lds + PB_OFF_P + rb * PB_P + lane * 16; float* L_lds = (float*)(lds + PB_OFF_L);
  float m_reg = mref, l_reg = 0.f, mn, al; f32x16 o[4] = {}; bf16x8 qr[8];
  const bf16* Qw = Qb + (long)(rb * QBLK + r32) * LDQ + hi * 8;
#pragma unroll
  for (int d0 = 0; d0 < 8; ++d0) qr[d0] = *reinterpret_cast<const bf16x8*>(Qw + d0 * 16);
  const int sr = tid >> 4, sc = (tid & 15) * 8, vst0 = v_st(sr, sc), vst1 = v_st(32 + sr, sc);
  const int vb0 = (int)(uintptr_t)V_lds + ch * 16384 + v_rd_base(lane);
  bf16x8 sv0, sv1, sv2, sv3, sk0, sk1;
  const unsigned koff0 = (unsigned)(sr * LDK + sc) * 2u, koff1 = koff0 + 32u * LDK * 2u, voff0 = (unsigned)(sr * LDV + sc) * 2u, voff1 = voff0 + 32u * LDV * 2u;
#define PLOADV(kt) do { const char* vb_ = (const char*)Vh + (size_t)(kt) * (64 * LDV * 2); sv0 = *(const bf16x8*)(vb_ + voff0); sv1 = *(const bf16x8*)(vb_ + voff1); sv2 = *(const bf16x8*)(vb_ + voff0 + 256); sv3 = *(const bf16x8*)(vb_ + voff1 + 256); } while (0)
#define PLOADK(kt) do { const char* kb_ = (const char*)Kh + (size_t)(kt) * (64 * LDK * 2); sk0 = *(const bf16x8*)(kb_ + koff0); sk1 = *(const bf16x8*)(kb_ + koff1); } while (0)
#define PWRITEV(b) do { char* d_ = V_lds + (b) * PB_V; *(bf16x8*)(d_ + vst0) = sv0; *(bf16x8*)(d_ + vst1) = sv1; *(bf16x8*)(d_ + 16384 + vst0) = sv2; *(bf16x8*)(d_ + 16384 + vst1) = sv3; } while (0)
#define PWRITEK(b) do { char* d_ = K_lds + (b) * PB_K; *(bf16x8*)(d_ + KSWZ(sr, sc * 2)) = sk0; *(bf16x8*)(d_ + KSWZ(32 + sr, sc * 2)) = sk1; } while (0)
#define PSTORE(par) do { char* d_ = P_lds + (par) * (4 * PB_P); *(bf16x8*)(d_) = pa0; *(bf16x8*)(d_ + 1024) = pa1; *(bf16x8*)(d_ + 2048) = pa2; *(bf16x8*)(d_ + 3072) = pa3; } while (0)
#define PFETCH(par) do { const char* d_ = P_lds + (par) * (4 * PB_P); pa0 = *(const bf16x8*)(d_); pa1 = *(const bf16x8*)(d_ + 1024); pa2 = *(const bf16x8*)(d_ + 2048); pa3 = *(const bf16x8*)(d_ + 3072); } while (0)
  const int NT = seq / KVBLK; f32x16 p0, p1; bf16x8 pa0, pa1, pa2, pa3;
  PLOADK(0); PLOADV(0); asm volatile("s_waitcnt vmcnt(0)" ::: "memory"); PWRITEK(0); PWRITEV(0);
  PLOADK(1); asm volatile("s_waitcnt vmcnt(0)" ::: "memory"); PWRITEK(1); __syncthreads();
  PLOADK(2); PLOADV(1);
  if (ch == 0) { qkt(p0, p1, (bf16*)K_lds, qr, r32, hi); partialSM(true, p0, p1, m_reg, mn, al); finishSM(p0, p1, 1.f, l_reg, pa0, pa1, pa2, pa3); PSTORE(0); }
  for (int t = 0; t < NT; ++t) {
    __syncthreads();
    asm volatile("s_waitcnt vmcnt(0)" ::: "memory");
    if (t + 2 < NT) PWRITEK(t & 1);
    if (t + 1 < NT) PWRITEV((t + 1) & 1);
    PLOADK(t + 3); PLOADV(t + 2);
    SBAR();
    const int vb = vb0 + (t & 1) * (int)PB_V;
    if ((t ^ ch) & 1) {
      const bool more = t + 1 < NT;
      PFETCH(t & 1);
      if (more) { qkt(p0, p1, (bf16*)(K_lds + ((t + 1) & 1) * PB_K), qr, r32, hi); partialSM(true, p0, p1, m_reg, mn, al); }
      pv_d0(o, vb, pa0, pa1, pa2, pa3);
      if (more) { finishSM(p0, p1, 1.f, l_reg, pa0, pa1, pa2, pa3); PSTORE((t + 1) & 1); }
    } else {
      pv_d0(o, vb, pa0, pa1, pa2, pa3);
    }
  }
  __syncthreads();
  int r32e = r32, hie = hi, wide = wid; asm volatile("" : "+v"(r32e), "+v"(hie), "+v"(wide));
  if (hie == 0) L_lds[wide * 32 + r32e] = l_reg;
  __syncthreads();
  const int rbe = wide & 3, che = wide >> 2;
  float rli[16];
#pragma unroll
  for (int r = 0; r < 16; ++r) { const int rr = crow(r, hie); rli[r] = __builtin_amdgcn_rcpf(L_lds[rbe * 32 + rr] + L_lds[(rbe + 4) * 32 + rr]); }
  float* rowp = Ob + (long)(rbe * QBLK + 4 * hie) * LDO + che * 128 + r32e;
#pragma unroll
  for (int g = 0; g < 4; ++g) { float* pg = rowp + (long)(8 * g) * LDO; asm volatile("" : "+v"(pg));
#pragma unroll
    for (int i = 0; i < 4; ++i)
#pragma unroll
      for (int d0 = 0; d0 < 4; ++d0) pg[(long)i * LDO + d0 * 32] = o[d0][4 * g + i] * rli[4 * g + i]; }
#undef PLOADV
#undef PLOADK
#undef PWRITEV
#undef PWRITEK
#undef PSTORE
#undef PFETCH
}

template <int LDQ, int LDK, int LDV, int LDO>
__device__ __forceinline__ void attn_pair2_body(const bf16* __restrict__ Qb, const bf16* __restrict__ Kh, const bf16* __restrict__ Vh, float* __restrict__ Ob, int seq, char* lds, float mref) {
  const int tid = threadIdx.x, wid = tid >> 6, lane = tid & 63, r32 = lane & 31, hi = lane >> 5, rb = wid & 3, ch = wid >> 2;
  char* V_lds = lds; char* K_lds = lds + PB_OFF_K; float* L_lds = (float*)(lds + PB_OFF_L);
  char* P_own = lds + PB_OFF_P + rb * PB_P + ch * 2048 + lane * 16; char* P_oth = lds + PB_OFF_P + rb * PB_P + (1 - ch) * 2048 + lane * 16;
  constexpr float C = SCALE * 1.4426950408889634f; const float mnC = -mref * C;
  float l_reg = 0.f; f32x16 o[4] = {}; bf16x8 qr[8];
  const bf16* Qw = Qb + (long)(rb * QBLK + r32) * LDQ + hi * 8;
#pragma unroll
  for (int d0 = 0; d0 < 8; ++d0) qr[d0] = *reinterpret_cast<const bf16x8*>(Qw + d0 * 16);
  const int sr = tid >> 4, sc = (tid & 15) * 8, vst0 = v_st(sr, sc), vst1 = v_st(32 + sr, sc);
  const int vb0 = (int)(uintptr_t)V_lds + ch * 16384 + v_rd_base(lane);
  const int kq = KSWZ(32 * ch + r32, hi * 16);
  bf16x8 sv0, sv1, sv2, sv3, sk0, sk1;
  const unsigned koff0 = (unsigned)(sr * LDK + sc) * 2u, koff1 = koff0 + 32u * LDK * 2u, voff0 = (unsigned)(sr * LDV + sc) * 2u, voff1 = voff0 + 32u * LDV * 2u;
#define PLOADV(kt) do { const char* vb_ = (const char*)Vh + (size_t)(kt) * (64 * LDV * 2); sv0 = *(const bf16x8*)(vb_ + voff0); sv1 = *(const bf16x8*)(vb_ + voff1); sv2 = *(const bf16x8*)(vb_ + voff0 + 256); sv3 = *(const bf16x8*)(vb_ + voff1 + 256); } while (0)
#define PLOADK(kt) do { const char* kb_ = (const char*)Kh + (size_t)(kt) * (64 * LDK * 2); sk0 = *(const bf16x8*)(kb_ + koff0); sk1 = *(const bf16x8*)(kb_ + koff1); } while (0)
#define PWRITEV(b) do { char* d_ = V_lds + (b) * PB_V; *(bf16x8*)(d_ + vst0) = sv0; *(bf16x8*)(d_ + vst1) = sv1; *(bf16x8*)(d_ + 16384 + vst0) = sv2; *(bf16x8*)(d_ + 16384 + vst1) = sv3; } while (0)
#define PWRITEK(b) do { char* d_ = K_lds + (b) * PB_K; *(bf16x8*)(d_ + KSWZ(sr, sc * 2)) = sk0; *(bf16x8*)(d_ + KSWZ(32 + sr, sc * 2)) = sk1; } while (0)
#define SCORE_MMA(kb) do { p = f32x16{}; const char* kp_ = K_lds + (kb) * PB_K + kq; \
    _Pragma("unroll") for (int d0 = 0; d0 < 8; ++d0) { const bf16x8 b_ = *reinterpret_cast<const bf16x8*>(kp_ + d0 * 32); p = __builtin_amdgcn_mfma_f32_32x32x16_bf16(b_, qr[d0], p, 0, 0, 0); } } while (0)
#define SCORE_SM(par) do { \
    _Pragma("unroll") for (int r = 0; r < 16; ++r) p[r] = __builtin_amdgcn_exp2f(fmaf(p[r], C, mnC)); \
    float ps_ = 0.f; _Pragma("unroll") for (int r = 0; r < 16; ++r) ps_ += p[r]; \
    { auto rr_ = __builtin_amdgcn_permlane32_swap(__float_as_uint(ps_), __float_as_uint(ps_), false, false); ps_ = __uint_as_float(rr_[0]) + __uint_as_float(rr_[1]); } l_reg += ps_; \
    { unsigned a0 = cvtpk(p[0], p[1]), a1 = cvtpk(p[2], p[3]), b0 = cvtpk(p[4], p[5]), b1 = cvtpk(p[6], p[7]); auto r0 = __builtin_amdgcn_permlane32_swap(a0, b0, false, false); auto r1 = __builtin_amdgcn_permlane32_swap(a1, b1, false, false); \
      u32x4 w = {r0[0], r1[0], r0[1], r1[1]}; pa0 = *reinterpret_cast<bf16x8*>(&w); } \
    { unsigned a0 = cvtpk(p[8], p[9]), a1 = cvtpk(p[10], p[11]), b0 = cvtpk(p[12], p[13]), b1 = cvtpk(p[14], p[15]); auto r0 = __builtin_amdgcn_permlane32_swap(a0, b0, false, false); auto r1 = __builtin_amdgcn_permlane32_swap(a1, b1, false, false); \
      u32x4 w = {r0[0], r1[0], r0[1], r1[1]}; pa1 = *reinterpret_cast<bf16x8*>(&w); } \
    { char* d_ = P_own + (par) * (4 * PB_P); *(bf16x8*)(d_) = pa0; *(bf16x8*)(d_ + 1024) = pa1; } } while (0)
  const int NT = seq / KVBLK; bf16x8 pa0, pa1; f32x16 p;
  PLOADK(0); PLOADV(0); asm volatile("s_waitcnt vmcnt(0)" ::: "memory"); PWRITEK(0); PWRITEV(0);
  PLOADK(1); asm volatile("s_waitcnt vmcnt(0)" ::: "memory"); PWRITEK(1); __syncthreads();
  PLOADK(2); PLOADV(1);
  SCORE_MMA(0); SCORE_SM(0);
  for (int t = 0; t < NT; ++t) {
    __syncthreads();
    bf16x8 pb0, pb1; { const char* d_ = P_oth + (t & 1) * (4 * PB_P); pb0 = *(const bf16x8*)(d_); pb1 = *(const bf16x8*)(d_ + 1024); }
    const bool more = t + 1 < NT;
    if (more) SCORE_MMA((t + 1) & 1);
    const bf16x8 A0 = ch ? pb0 : pa0, A1 = ch ? pb1 : pa1, A2 = ch ? pa0 : pb0, A3 = ch ? pa1 : pb1;
    const int vb = vb0 + (t & 1) * (int)PB_V;
    SBAR(); pv_two<0>(o[0], o[1], vb, A0, A1, A2, A3); SBAR();
    asm volatile("s_waitcnt vmcnt(0)" ::: "memory");
    if (t + 2 < NT) PWRITEK(t & 1);
    if (t + 1 < NT) PWRITEV((t + 1) & 1);
    PLOADK(t + 3); PLOADV(t + 2);
    SBAR(); pv_two<2>(o[2], o[3], vb, A0, A1, A2, A3); SBAR();
    if (more) SCORE_SM((t + 1) & 1);
  }
  __syncthreads();
  int r32e = r32, hie = hi, wide = wid; asm volatile("" : "+v"(r32e), "+v"(hie), "+v"(wide));
  if (hie == 0) L_lds[wide * 32 + r32e] = l_reg;
  __syncthreads();
  const int rbe = wide & 3, che = wide >> 2;
  float rli[16];
#pragma unroll
  for (int r = 0; r < 16; ++r) { const int rr = crow(r, hie); rli[r] = __builtin_amdgcn_rcpf(L_lds[rbe * 32 + rr] + L_lds[(rbe + 4) * 32 + rr]); }
  float* rowp = Ob + (long)(rbe * QBLK + 4 * hie) * LDO + che * 128 + r32e;
#pragma unroll
  for (int g = 0; g < 4; ++g) { float* pg = rowp + (long)(8 * g) * LDO; asm volatile("" : "+v"(pg));
#pragma unroll
    for (int i = 0; i < 4; ++i)
#pragma unroll
      for (int d0 = 0; d0 < 4; ++d0) pg[(long)i * LDO + d0 * 32] = o[d0][4 * g + i] * rli[4 * g + i]; }
#undef PLOADV
#undef PLOADK
#undef PWRITEV
#undef PWRITEK
#undef SCORE_MMA
#undef SCORE_SM
}

template <int LDQ, int LDK, int LDV, int LDO, int DMX>
__device__ __forceinline__ void attn_diff2_body(const bf16* __restrict__ Qb0, const bf16* __restrict__ Kh0, const bf16* __restrict__ Vh, float* __restrict__ Ob, bf16* __restrict__ Mx, int seq, char* lds, float mref, float lam, float osc, const float* __restrict__ sg) {
  const int tid = threadIdx.x, wid = tid >> 6, lane = tid & 63, r32 = lane & 31, hi = lane >> 5, rb = wid & 3, ch = wid >> 2;
  char* V_lds = lds; char* K_lds = lds + PB_OFF_K; float* L_lds = (float*)(lds + PB_OFF_L);
  char* P_own = lds + PB_OFF_P + rb * PB_P + ch * 2048 + lane * 16; char* P_oth = lds + PB_OFF_P + rb * PB_P + (1 - ch) * 2048 + lane * 16;
  constexpr float C = SCALE * 1.4426950408889634f; const float mnC = -mref * C;
  float* S_lds = L_lds + 8 * 32;
  const int sr = tid >> 4, sc = (tid & 15) * 8, vst0 = v_st(sr, sc), vst1 = v_st(32 + sr, sc);
  const int vb0 = (int)(uintptr_t)V_lds + ch * 16384 + v_rd_base(lane);
  const int kq = KSWZ(32 * ch + r32, hi * 16);
  bf16x8 sv0, sv1, sv2, sv3, sk0, sk1;
  const unsigned koff0 = (unsigned)(sr * LDK + sc) * 2u, koff1 = koff0 + 32u * LDK * 2u, voff0 = (unsigned)(sr * LDV + sc) * 2u, voff1 = voff0 + 32u * LDV * 2u;
#define PLOADV(kt) do { const char* vb_ = (const char*)Vh + (size_t)(kt) * (64 * LDV * 2); sv0 = *(const bf16x8*)(vb_ + voff0); sv1 = *(const bf16x8*)(vb_ + voff1); sv2 = *(const bf16x8*)(vb_ + voff0 + 256); sv3 = *(const bf16x8*)(vb_ + voff1 + 256); } while (0)
#define PLOADK(kt) do { const char* kb_ = (const char*)Kh + (size_t)(kt) * (64 * LDK * 2); sk0 = *(const bf16x8*)(kb_ + koff0); sk1 = *(const bf16x8*)(kb_ + koff1); } while (0)
#define PWRITEV(b) do { char* d_ = V_lds + (b) * PB_V; *(bf16x8*)(d_ + vst0) = sv0; *(bf16x8*)(d_ + vst1) = sv1; *(bf16x8*)(d_ + 16384 + vst0) = sv2; *(bf16x8*)(d_ + 16384 + vst1) = sv3; } while (0)
#define PWRITEK(b) do { char* d_ = K_lds + (b) * PB_K; *(bf16x8*)(d_ + KSWZ(sr, sc * 2)) = sk0; *(bf16x8*)(d_ + KSWZ(32 + sr, sc * 2)) = sk1; } while (0)
#define SCORE_MMA(kb) do { p = f32x16{}; const char* kp_ = K_lds + (kb) * PB_K + kq; \
    _Pragma("unroll") for (int d0 = 0; d0 < 8; ++d0) { const bf16x8 b_ = *reinterpret_cast<const bf16x8*>(kp_ + d0 * 32); p = __builtin_amdgcn_mfma_f32_32x32x16_bf16(b_, qr[d0], p, 0, 0, 0); } } while (0)
#define SCORE_SM(par) do { \
    _Pragma("unroll") for (int r = 0; r < 16; ++r) p[r] = __builtin_amdgcn_exp2f(fmaf(p[r], C, mnC)); \
    float ps_ = 0.f; _Pragma("unroll") for (int r = 0; r < 16; ++r) ps_ += p[r]; \
    { auto rr_ = __builtin_amdgcn_permlane32_swap(__float_as_uint(ps_), __float_as_uint(ps_), false, false); ps_ = __uint_as_float(rr_[0]) + __uint_as_float(rr_[1]); } l_reg += ps_; \
    { unsigned a0 = cvtpk(p[0], p[1]), a1 = cvtpk(p[2], p[3]), b0 = cvtpk(p[4], p[5]), b1 = cvtpk(p[6], p[7]); auto r0 = __builtin_amdgcn_permlane32_swap(a0, b0, false, false); auto r1 = __builtin_amdgcn_permlane32_swap(a1, b1, false, false); \
      u32x4 w = {r0[0], r1[0], r0[1], r1[1]}; pa0 = *reinterpret_cast<bf16x8*>(&w); } \
    { unsigned a0 = cvtpk(p[8], p[9]), a1 = cvtpk(p[10], p[11]), b0 = cvtpk(p[12], p[13]), b1 = cvtpk(p[14], p[15]); auto r0 = __builtin_amdgcn_permlane32_swap(a0, b0, false, false); auto r1 = __builtin_amdgcn_permlane32_swap(a1, b1, false, false); \
      u32x4 w = {r0[0], r1[0], r0[1], r1[1]}; pa1 = *reinterpret_cast<bf16x8*>(&w); } \
    { char* d_ = P_own + (par) * (4 * PB_P); *(bf16x8*)(d_) = pa0; *(bf16x8*)(d_ + 1024) = pa1; } } while (0)
  const int NT = seq / KVBLK;
#pragma unroll 1
  for (int pass = 0; pass < 2; ++pass) {
  const bf16* Kh = Kh0 + pass * 128; bf16x8 pa0, pa1; f32x16 p;
  float l_reg = 0.f; f32x16 o[4] = {}; bf16x8 qr[8];
  { int r32q = r32, hiq = hi, widq = wid; asm volatile("" : "+v"(r32q), "+v"(hiq), "+v"(widq));
    const bf16* Qw = Qb0 + pass * 128 + (long)((widq & 3) * QBLK + r32q) * LDQ + hiq * 8;
#pragma unroll
    for (int d0 = 0; d0 < 8; ++d0) qr[d0] = *reinterpret_cast<const bf16x8*>(Qw + d0 * 16); }
  PLOADK(0); PLOADV(0); asm volatile("s_waitcnt vmcnt(0)" ::: "memory"); PWRITEK(0); PWRITEV(0);
  PLOADK(1); asm volatile("s_waitcnt vmcnt(0)" ::: "memory"); PWRITEK(1); __syncthreads();
  PLOADK(2); PLOADV(1);
  SCORE_MMA(0); SCORE_SM(0);
  if (wid >= 4) __builtin_amdgcn_s_setprio(1);
  for (int t = 0; t < NT; ++t) {
    __syncthreads();
    bf16x8 pb0, pb1; { const char* d_ = P_oth + (t & 1) * (4 * PB_P); pb0 = *(const bf16x8*)(d_); pb1 = *(const bf16x8*)(d_ + 1024); }
    const bool more = t + 1 < NT;
    if (more) SCORE_MMA((t + 1) & 1);
    const bf16x8 A0 = ch ? pb0 : pa0, A1 = ch ? pb1 : pa1, A2 = ch ? pa0 : pb0, A3 = ch ? pa1 : pb1;
    const int vb = vb0 + (t & 1) * (int)PB_V;
    SBAR(); pv_two<0>(o[0], o[1], vb, A0, A1, A2, A3); SBAR();
    asm volatile("s_waitcnt vmcnt(0)" ::: "memory");
    if (t + 2 < NT) PWRITEK(t & 1);
    if (t + 1 < NT) PWRITEV((t + 1) & 1);
    PLOADK(t + 3); PLOADV(t + 2);
    SBAR(); pv_two<2>(o[2], o[3], vb, A0, A1, A2, A3); SBAR();
    if (more) SCORE_SM((t + 1) & 1);
  }
  __builtin_amdgcn_s_setprio(0);
  __syncthreads();
  int r32e = r32, hie = hi, wide = wid; asm volatile("" : "+v"(r32e), "+v"(hie), "+v"(wide));
  if (hie == 0) L_lds[wide * 32 + r32e] = l_reg;
  __syncthreads();
  const int rbe = wide & 3, che = wide >> 2;
  float rli[16];
#pragma unroll
  for (int r = 0; r < 16; ++r) { const int rr = crow(r, hie); rli[r] = __builtin_amdgcn_rcpf(L_lds[rbe * 32 + rr] + L_lds[(rbe + 4) * 32 + rr]); }
  float* rowp = Ob + (long)(rbe * QBLK + 4 * hie) * LDO + che * 128 + r32e;
  if (pass == 0) {
#pragma unroll
    for (int g = 0; g < 4; ++g) { float* pg = rowp + (long)(8 * g) * LDO; asm volatile("" : "+v"(pg));
#pragma unroll
      for (int i = 0; i < 4; ++i)
#pragma unroll
        for (int d0 = 0; d0 < 4; ++d0) pg[(long)i * LDO + d0 * 32] = o[d0][4 * g + i] * rli[4 * g + i]; }
  } else {
    float ssq[16];
#pragma unroll
    for (int g = 0; g < 4; ++g) { const float* pg = rowp + (long)(8 * g) * LDO; asm volatile("" : "+v"(pg));
#pragma unroll
      for (int i = 0; i < 4; ++i) { float q_ = 0.f;
#pragma unroll
        for (int d0 = 0; d0 < 4; ++d0) { const float v = pg[(long)i * LDO + d0 * 32] - lam * (o[d0][4 * g + i] * rli[4 * g + i]); o[d0][4 * g + i] = v; q_ += v * v; }
        ssq[4 * g + i] = q_; } }
#pragma unroll
    for (int r = 0; r < 16; ++r) { float q_ = ssq[r];
#pragma unroll
      for (int m_ = 1; m_ < 32; m_ <<= 1) q_ += __shfl_xor(q_, m_);
      ssq[r] = q_; }
    if (r32e == 0) {
#pragma unroll
      for (int r = 0; r < 16; ++r) S_lds[wide * 32 + crow(r, hie)] = ssq[r]; }
    __syncthreads();
    bf16* mrow = Mx + (long)(rbe * QBLK + 4 * hie) * DMX + che * 128 + r32e;
    float sgv[4];
#pragma unroll
    for (int d0 = 0; d0 < 4; ++d0) sgv[d0] = sg[che * 128 + d0 * 32 + r32e];
#pragma unroll
    for (int g = 0; g < 4; ++g) { bf16* pm_ = mrow + (long)(8 * g) * DMX; asm volatile("" : "+v"(pm_));
#pragma unroll
      for (int i = 0; i < 4; ++i) { const int rr = 8 * g + i + 4 * hie; const float sc_ = osc / sqrtf((S_lds[rbe * 32 + rr] + S_lds[(rbe + 4) * 32 + rr]) * (1.0f / 256.0f) + 1e-6f);
#pragma unroll
        for (int d0 = 0; d0 < 4; ++d0) { const float v = o[d0][4 * g + i] * sc_ * sgv[d0]; unsigned u = __float_as_uint(v); u = (u + 0x7fffu + ((u >> 16) & 1u)) >> 16; pm_[(long)i * DMX + d0 * 32] = (bf16)u; } } }
  }
  __syncthreads();
  }
#undef PLOADV
#undef PLOADK
#undef PWRITEV
#undef PWRITEK
#undef SCORE_MMA
#undef SCORE_SM
}


constexpr size_t GB_V = 16384, GB_K = KVBLK * 272, GB_OFF_K = 2 * GB_V, SHM_GQA2 = GB_OFF_K + 2 * GB_K;
template <int LDQ, int LDK, int LDO>
__device__ __forceinline__ void attn_gqa2_body(const bf16* __restrict__ Qb, const bf16* __restrict__ Kh, const bf16* __restrict__ Vh, bf16* __restrict__ Ob, int seq, char* lds, float mref) {
  const int tid = threadIdx.x, wid = tid >> 6, lane = tid & 63, r32 = lane & 31, hi = lane >> 5;
  char* V_lds = lds; char* K_lds = lds + GB_OFF_K;
  constexpr float C = SCALE * 1.4426950408889634f; const float mnC = -mref * C;
  float l_reg = 0.f; f32x16 o[4] = {}; bf16x8 qr[8];
  { int r32q = r32, hiq = hi, widq = wid; asm volatile("" : "+v"(r32q), "+v"(hiq), "+v"(widq));
    const bf16* Qw = Qb + (widq >> 2) * 128 + (long)((widq & 3) * QBLK + r32q) * LDQ + hiq * 8;
#pragma unroll
    for (int d0 = 0; d0 < 8; ++d0) qr[d0] = *reinterpret_cast<const bf16x8*>(Qw + d0 * 16); }
  const int sr = tid >> 4, sc = (tid & 15) * 8, vst0 = v_st(sr, sc), vst1 = v_st(32 + sr, sc);
  const int vb0 = (int)(uintptr_t)V_lds + v_rd_base(lane);
  bf16x8 sv0, sv1, sk0, sk1;
  const unsigned koff0 = (unsigned)(sr * LDK + sc) * 2u, koff1 = koff0 + 32u * LDK * 2u;
#define GLOADV(kt) do { const char* vb_ = (const char*)Vh + (size_t)(kt) * (64 * LDK * 2); sv0 = *(const bf16x8*)(vb_ + koff0); sv1 = *(const bf16x8*)(vb_ + koff1); } while (0)
#define GLOADK(kt) do { const char* kb_ = (const char*)Kh + (size_t)(kt) * (64 * LDK * 2); sk0 = *(const bf16x8*)(kb_ + koff0); sk1 = *(const bf16x8*)(kb_ + koff1); } while (0)
#define GWRITEV(b) do { char* d_ = V_lds + (b) * GB_V; *(bf16x8*)(d_ + vst0) = sv0; *(bf16x8*)(d_ + vst1) = sv1; } while (0)
#define GWRITEK(b) do { char* d_ = K_lds + (b) * GB_K; *(bf16x8*)(d_ + KSWZ(sr, sc * 2)) = sk0; *(bf16x8*)(d_ + KSWZ(32 + sr, sc * 2)) = sk1; } while (0)
#define GSCORE_SM() do { \
    _Pragma("unroll") for (int r = 0; r < 16; ++r) { p0[r] = __builtin_amdgcn_exp2f(fmaf(p0[r], C, mnC)); p1[r] = __builtin_amdgcn_exp2f(fmaf(p1[r], C, mnC)); } \
    finishSM(p0, p1, 1.f, l_reg, pa0, pa1, pa2, pa3); } while (0)
  const int NT = seq / KVBLK; bf16x8 pa0, pa1, pa2, pa3; f32x16 p0, p1;
  GLOADK(0); GLOADV(0); asm volatile("s_waitcnt vmcnt(0)" ::: "memory"); GWRITEK(0); GWRITEV(0);
  GLOADK(1); asm volatile("s_waitcnt vmcnt(0)" ::: "memory"); GWRITEK(1); __syncthreads();
  GLOADK(2); GLOADV(1);
  qkt(p0, p1, (bf16*)K_lds, qr, r32, hi);
  { _Pragma("unroll") for (int r = 0; r < 16; ++r) { p0[r] = __builtin_amdgcn_exp2f(fmaf(p0[r], C, mnC)); p1[r] = __builtin_amdgcn_exp2f(fmaf(p1[r], C, mnC)); } }
  if (wid >= 4) __builtin_amdgcn_s_setprio(1);
  for (int t = 0; t < NT; ++t) {
    finishSM_noexp(p0, p1, l_reg, pa0, pa1, pa2, pa3);
    __syncthreads();
    const bool more = t + 1 < NT;
    if (more) qkt(p0, p1, (bf16*)(K_lds + ((t + 1) & 1) * GB_K), qr, r32, hi);
    const int vb = vb0 + (t & 1) * (int)GB_V;
    SBAR(); pv_two<0>(o[0], o[1], vb, pa0, pa1, pa2, pa3); SBAR();
    asm volatile("s_waitcnt vmcnt(0)" ::: "memory");
    if (t + 2 < NT) GWRITEK(t & 1);
    if (t + 1 < NT) GWRITEV((t + 1) & 1);
    GLOADK(t + 3); GLOADV(t + 2);
    SBAR(); pv_two<2>(o[2], o[3], vb, pa0, pa1, pa2, pa3); SBAR();
    if (more) { _Pragma("unroll") for (int r = 0; r < 16; ++r) { p0[r] = __builtin_amdgcn_exp2f(fmaf(p0[r], C, mnC)); p1[r] = __builtin_amdgcn_exp2f(fmaf(p1[r], C, mnC)); } }
  }
  __builtin_amdgcn_s_setprio(0);
  int r32e = r32, hie = hi, wide = wid; asm volatile("" : "+v"(r32e), "+v"(hie), "+v"(wide));
  float* li_l = (float*)(lds + SHM_GQA2) + wide * 32;
  __syncthreads();
  if (hie == 0) li_l[r32e] = l_reg;
  asm volatile("s_waitcnt lgkmcnt(0)" ::: "memory");
  float rli[16];
#pragma unroll
  for (int r = 0; r < 16; ++r) rli[r] = __builtin_amdgcn_rcpf(li_l[crow(r, hie)]);
  bf16* Ow = Ob + (wide >> 2) * 128 + (long)((wide & 3) * QBLK + 4 * hie) * LDO + r32e;
#pragma unroll
  for (int r = 0; r < 16; ++r) { const int orow = (r & 3) + 8 * (r >> 2);
#pragma unroll
    for (int d0 = 0; d0 < 4; ++d0) { const float v = o[d0][r] * rli[r]; unsigned u = __float_as_uint(v); u = (u + 0x7fffu + ((u >> 16) & 1u)) >> 16; Ow[(long)orow * LDO + d0 * 32] = (bf16)u; } }
#undef GLOADV
#undef GLOADK
#undef GWRITEV
#undef GWRITEK
#undef GSCORE_SM
}

constexpr int VP16 = 2080;
using f32x4a = __attribute__((ext_vector_type(4))) float; using u32x2a = __attribute__((ext_vector_type(2))) unsigned;
constexpr size_t G16_V = 8 * VP16, G16_OFF_K = 2 * G16_V, SHM_G16 = G16_OFF_K + 2 * GB_K;
#define MFMA16(a, b, c) __builtin_amdgcn_mfma_f32_16x16x32_bf16(a, b, c, 0, 0, 0)
#define PK16(L, H) (bf16x8){L[0], L[1], L[2], L[3], H[0], H[1], H[2], H[3]}
template <int D0> __device__ __forceinline__ void pv16(f32x4a (&o)[8][2], int vb, const bf16x8 (&pb)[2][2]) {
#define TR(dt, j, h) tr_read<(dt) * VP16 + (j) * 1024 + (h) * 512>(vb)
  const s16x4 a0 = TR(D0, 0, 0), a1 = TR(D0, 0, 1), a2 = TR(D0, 1, 0), a3 = TR(D0, 1, 1), b0 = TR(D0 + 1, 0, 0), b1 = TR(D0 + 1, 0, 1), b2 = TR(D0 + 1, 1, 0), b3 = TR(D0 + 1, 1, 1);
  const s16x4 c0 = TR(D0 + 2, 0, 0), c1 = TR(D0 + 2, 0, 1), c2 = TR(D0 + 2, 1, 0), c3 = TR(D0 + 2, 1, 1);
  asm volatile("s_waitcnt lgkmcnt(4)" ::: "memory"); SBAR();
  o[D0][0] = MFMA16(PK16(a0, a1), pb[0][0], o[D0][0]); o[D0][1] = MFMA16(PK16(a0, a1), pb[0][1], o[D0][1]);
  o[D0 + 1][0] = MFMA16(PK16(b0, b1), pb[0][0], o[D0 + 1][0]); o[D0 + 1][1] = MFMA16(PK16(b0, b1), pb[0][1], o[D0 + 1][1]);
  o[D0][0] = MFMA16(PK16(a2, a3), pb[1][0], o[D0][0]); o[D0][1] = MFMA16(PK16(a2, a3), pb[1][1], o[D0][1]);
  o[D0 + 1][0] = MFMA16(PK16(b2, b3), pb[1][0], o[D0 + 1][0]); o[D0 + 1][1] = MFMA16(PK16(b2, b3), pb[1][1], o[D0 + 1][1]);
  SBAR();
  const s16x4 d0 = TR(D0 + 3, 0, 0), d1 = TR(D0 + 3, 0, 1), d2 = TR(D0 + 3, 1, 0), d3 = TR(D0 + 3, 1, 1);
  asm volatile("s_waitcnt lgkmcnt(4)" ::: "memory"); SBAR();
  o[D0 + 2][0] = MFMA16(PK16(c0, c1), pb[0][0], o[D0 + 2][0]); o[D0 + 2][1] = MFMA16(PK16(c0, c1), pb[0][1], o[D0 + 2][1]);
  o[D0 + 2][0] = MFMA16(PK16(c2, c3), pb[1][0], o[D0 + 2][0]); o[D0 + 2][1] = MFMA16(PK16(c2, c3), pb[1][1], o[D0 + 2][1]);
  asm volatile("s_waitcnt lgkmcnt(0)" ::: "memory"); SBAR();
  o[D0 + 3][0] = MFMA16(PK16(d0, d1), pb[0][0], o[D0 + 3][0]); o[D0 + 3][1] = MFMA16(PK16(d0, d1), pb[0][1], o[D0 + 3][1]);
  o[D0 + 3][0] = MFMA16(PK16(d2, d3), pb[1][0], o[D0 + 3][0]); o[D0 + 3][1] = MFMA16(PK16(d2, d3), pb[1][1], o[D0 + 3][1]);
#undef TR
}
template <int LDQ, int LDK, int LDO>
__device__ __forceinline__ void attn_gqa16_body(const bf16* __restrict__ Qb, const bf16* __restrict__ Kh, const bf16* __restrict__ Vh, bf16* __restrict__ Ob, int seq, char* lds, float mref) {
  const int tid = threadIdx.x, wid = tid >> 6, lane = tid & 63, l16 = lane & 15, g = lane >> 4;
  char* V_lds = lds; char* K_lds = lds + G16_OFF_K;
  constexpr float C = SCALE * 1.4426950408889634f; const float mnC = -mref * C;
  float ls0 = 0.f, ls1 = 0.f; f32x4a o[8][2] = {}; bf16x8 qr[2][4];
  { int l16q = l16, gq = g, widq = wid; asm volatile("" : "+v"(l16q), "+v"(gq), "+v"(widq));
    const bf16* Qw = Qb + (widq >> 2) * 128 + (long)((widq & 3) * QBLK + l16q) * LDQ + gq * 8;
#pragma unroll
    for (int qt = 0; qt < 2; ++qt)
#pragma unroll
      for (int ds = 0; ds < 4; ++ds) qr[qt][ds] = *reinterpret_cast<const bf16x8*>(Qw + (long)qt * 16 * LDQ + ds * 32); }
  const int sr = tid >> 4, sc = (tid & 15) * 8;
  const int vst0 = (sc >> 4) * VP16 + sr * 32 + ((sc >> 3) & 1) * 16, vst1 = vst0 + 1024;
  const int vb0 = (int)(uintptr_t)V_lds + (4 * g + (l16 >> 2)) * 32 + (l16 & 3) * 8;
  const int kb0 = l16 * 272 + g * 16;
  bf16x8 sv0, sv1, sk0, sk1;
  const unsigned koff0 = (unsigned)(sr * LDK + sc) * 2u, koff1 = koff0 + 32u * LDK * 2u;
#define HLOADV(kt) do { const char* vb_ = (const char*)Vh + (size_t)(kt) * (64 * LDK * 2); sv0 = *(const bf16x8*)(vb_ + koff0); sv1 = *(const bf16x8*)(vb_ + koff1); } while (0)
#define HLOADK(kt) do { const char* kb_ = (const char*)Kh + (size_t)(kt) * (64 * LDK * 2); sk0 = *(const bf16x8*)(kb_ + koff0); sk1 = *(const bf16x8*)(kb_ + koff1); } while (0)
#define HWRITEV(b) do { char* d_ = V_lds + (b) * G16_V; *(bf16x8*)(d_ + vst0) = sv0; *(bf16x8*)(d_ + vst1) = sv1; } while (0)
#define HWRITEK(b) do { char* d_ = K_lds + (b) * GB_K; *(bf16x8*)(d_ + KSWZ(sr, sc * 2)) = sk0; *(bf16x8*)(d_ + KSWZ(32 + sr, sc * 2)) = sk1; } while (0)
  f32x4a s[4][2]; bf16x8 pb[2][2];
#define HQK(kbuf) do { const char* kp_ = K_lds + (kbuf) * GB_K + kb0; \
    _Pragma("unroll") for (int kt = 0; kt < 4; ++kt) { s[kt][0] = f32x4a{0.f, 0.f, 0.f, 0.f}; s[kt][1] = f32x4a{0.f, 0.f, 0.f, 0.f}; } \
    _Pragma("unroll") for (int ds = 0; ds < 4; ++ds) { \
      _Pragma("unroll") for (int kt = 0; kt < 4; ++kt) { const bf16x8 a_ = *reinterpret_cast<const bf16x8*>(kp_ + kt * (16 * 272) + ds * 64); \
        s[kt][0] = MFMA16(a_, qr[0][ds], s[kt][0]); s[kt][1] = MFMA16(a_, qr[1][ds], s[kt][1]); } } } while (0)
#define HEXP() do { _Pragma("unroll") for (int kt = 0; kt < 4; ++kt) { _Pragma("unroll") for (int qt = 0; qt < 2; ++qt) { _Pragma("unroll") for (int i = 0; i < 4; ++i) s[kt][qt][i] = __builtin_amdgcn_exp2f(fmaf(s[kt][qt][i], C, mnC)); } } } while (0)
#define HPACK() do { \
    _Pragma("unroll") for (int kt = 0; kt < 4; ++kt) { ls0 += (s[kt][0][0] + s[kt][0][1]) + (s[kt][0][2] + s[kt][0][3]); ls1 += (s[kt][1][0] + s[kt][1][1]) + (s[kt][1][2] + s[kt][1][3]); } \
    _Pragma("unroll") for (int j = 0; j < 2; ++j) { _Pragma("unroll") for (int qt = 0; qt < 2; ++qt) { \
      u32x4 w_ = {cvtpk(s[2 * j][qt][0], s[2 * j][qt][1]), cvtpk(s[2 * j][qt][2], s[2 * j][qt][3]), cvtpk(s[2 * j + 1][qt][0], s[2 * j + 1][qt][1]), cvtpk(s[2 * j + 1][qt][2], s[2 * j + 1][qt][3])}; \
      pb[j][qt] = *reinterpret_cast<bf16x8*>(&w_); } } } while (0)
  const int NT = seq / KVBLK;
  HLOADK(0); HLOADV(0); asm volatile("s_waitcnt vmcnt(0)" ::: "memory"); HWRITEK(0); HWRITEV(0);
  HLOADK(1); asm volatile("s_waitcnt vmcnt(0)" ::: "memory"); HWRITEK(1); __syncthreads();
  HLOADK(2); HLOADV(1);
  HQK(0); HEXP();
  if (wid >= 4) __builtin_amdgcn_s_setprio(1);
  for (int t = 0; t < NT; ++t) {
    HPACK();
    __syncthreads();
    const bool more = t + 1 < NT;
    if (more) HQK((t + 1) & 1);
    const int vb = vb0 + (t & 1) * (int)G16_V;
    SBAR(); pv16<0>(o, vb, pb); SBAR();
    asm volatile("s_waitcnt vmcnt(0)" ::: "memory");
    if (t + 2 < NT) HWRITEK(t & 1);
    if (t + 1 < NT) HWRITEV((t + 1) & 1);
    HLOADK(t + 3); HLOADV(t + 2);
    SBAR(); pv16<4>(o, vb, pb); SBAR();
    if (more) HEXP();
  }
  __builtin_amdgcn_s_setprio(0);
  ls0 += __shfl_xor(ls0, 16); ls0 += __shfl_xor(ls0, 32); ls1 += __shfl_xor(ls1, 16); ls1 += __shfl_xor(ls1, 32);
  const float rl[2] = {__builtin_amdgcn_rcpf(ls0), __builtin_amdgcn_rcpf(ls1)};
  int l16e = l16, ge = g, wide = wid; asm volatile("" : "+v"(l16e), "+v"(ge), "+v"(wide));
  bf16* Ow = Ob + (wide >> 2) * 128 + (long)((wide & 3) * QBLK + l16e) * LDO + 4 * ge;
#pragma unroll
  for (int qt = 0; qt < 2; ++qt)
#pragma unroll
    for (int dt = 0; dt < 8; ++dt) { unsigned u_[4];
#pragma unroll
      for (int i = 0; i < 4; ++i) { const float v = o[dt][qt][i] * rl[qt]; unsigned u = __float_as_uint(v); u_[i] = (u + 0x7fffu + ((u >> 16) & 1u)) >> 16; }
      u32x2a w_ = {u_[0] | (u_[1] << 16), u_[2] | (u_[3] << 16)};
      *reinterpret_cast<u32x2a*>(Ow + (long)qt * 16 * LDO + dt * 16) = w_; }
#undef HLOADV
#undef HLOADK
#undef HWRITEV
#undef HWRITEK
#undef HQK
#undef HEXP
#undef HPACK
}

constexpr size_t D16_V = 16 * VP16, D16_OFF_K = 2 * D16_V, D16_OFF_P = D16_OFF_K + 2 * PB_K, D16_OFF_L = D16_OFF_P + 8 * PB_P, SHM_D16 = D16_OFF_L + 2 * 8 * 32 * 4;
template <int D0> __device__ __forceinline__ void pv16d(f32x4a (&o)[8][2], int vbo, int vbp, const bf16x8 (&po)[2], const bf16x8 (&pp)[2]) {
#define TRO(dt, h) tr_read<(dt) * VP16 + (h) * 512>(vbo)
#define TRP(dt, h) tr_read<(dt) * VP16 + (h) * 512>(vbp)
  const s16x4 a0 = TRO(D0, 0), a1 = TRO(D0, 1), a2 = TRP(D0, 0), a3 = TRP(D0, 1), b0 = TRO(D0 + 1, 0), b1 = TRO(D0 + 1, 1), b2 = TRP(D0 + 1, 0), b3 = TRP(D0 + 1, 1);
  const s16x4 c0 = TRO(D0 + 2, 0), c1 = TRO(D0 + 2, 1), c2 = TRP(D0 + 2, 0), c3 = TRP(D0 + 2, 1);
  asm volatile("s_waitcnt lgkmcnt(4)" ::: "memory"); SBAR();
  o[D0][0] = MFMA16(PK16(a0, a1), po[0], o[D0][0]); o[D0][1] = MFMA16(PK16(a0, a1), po[1], o[D0][1]);
  o[D0 + 1][0] = MFMA16(PK16(b0, b1), po[0], o[D0 + 1][0]); o[D0 + 1][1] = MFMA16(PK16(b0, b1), po[1], o[D0 + 1][1]);
  o[D0][0] = MFMA16(PK16(a2, a3), pp[0], o[D0][0]); o[D0][1] = MFMA16(PK16(a2, a3), pp[1], o[D0][1]);
  o[D0 + 1][0] = MFMA16(PK16(b2, b3), pp[0], o[D0 + 1][0]); o[D0 + 1][1] = MFMA16(PK16(b2, b3), pp[1], o[D0 + 1][1]);
  SBAR();
  const s16x4 d0 = TRO(D0 + 3, 0), d1 = TRO(D0 + 3, 1), d2 = TRP(D0 + 3, 0), d3 = TRP(D0 + 3, 1);
  asm volatile("s_waitcnt lgkmcnt(4)" ::: "memory"); SBAR();
  o[D0 + 2][0] = MFMA16(PK16(c0, c1), po[0], o[D0 + 2][0]); o[D0 + 2][1] = MFMA16(PK16(c0, c1), po[1], o[D0 + 2][1]);
  o[D0 + 2][0] = MFMA16(PK16(c2, c3), pp[0], o[D0 + 2][0]); o[D0 + 2][1] = MFMA16(PK16(c2, c3), pp[1], o[D0 + 2][1]);
  asm volatile("s_waitcnt lgkmcnt(0)" ::: "memory"); SBAR();
  o[D0 + 3][0] = MFMA16(PK16(d0, d1), po[0], o[D0 + 3][0]); o[D0 + 3][1] = MFMA16(PK16(d0, d1), po[1], o[D0 + 3][1]);
  o[D0 + 3][0] = MFMA16(PK16(d2, d3), pp[0], o[D0 + 3][0]); o[D0 + 3][1] = MFMA16(PK16(d2, d3), pp[1], o[D0 + 3][1]);
#undef TRO
#undef TRP
}
template <int LDQ, int LDK, int LDV, int LDO, int DMX>
__device__ __forceinline__ void attn_diff16_body(const bf16* __restrict__ Qb0, const bf16* __restrict__ Kh0, const bf16* __restrict__ Vh, float* __restrict__ Ob, bf16* __restrict__ Mx, int seq, char* lds, float mref, float lam, float osc, const float* __restrict__ sg) {
  const int tid = threadIdx.x, wid = tid >> 6, lane = tid & 63, l16 = lane & 15, g = lane >> 4, rb = wid & 3, ch = wid >> 2;
  char* V_lds = lds; char* K_lds = lds + D16_OFF_K; float* L_lds = (float*)(lds + D16_OFF_L); float* S_lds = L_lds + 8 * 32;
  char* P_own = lds + D16_OFF_P + rb * PB_P + ch * 2048 + lane * 16; char* P_oth = lds + D16_OFF_P + rb * PB_P + (1 - ch) * 2048 + lane * 16;
  constexpr float C = SCALE * 1.4426950408889634f; const float mnC = -mref * C;
  const int sr = tid >> 4, sc = (tid & 15) * 8;
  const int vst0 = (sc >> 4) * VP16 + sr * 32 + ((sc >> 3) & 1) * 16, vst1 = vst0 + 1024;
  const int vlane = (int)(uintptr_t)V_lds + ch * (8 * VP16) + (4 * g + (l16 >> 2)) * 32 + (l16 & 3) * 8;
  const int kb0 = (32 * ch + l16) * 272 + g * 16;
  bf16x8 sv0, sv1, sv2, sv3, sk0, sk1;
  const unsigned koff0 = (unsigned)(sr * LDK + sc) * 2u, koff1 = koff0 + 32u * LDK * 2u, voff0 = (unsigned)(sr * LDV + sc) * 2u, voff1 = voff0 + 32u * LDV * 2u;
#define ELOADV(kt) do { const char* vb_ = (const char*)Vh + (size_t)(kt) * (64 * LDV * 2); sv0 = *(const bf16x8*)(vb_ + voff0); sv1 = *(const bf16x8*)(vb_ + voff1); sv2 = *(const bf16x8*)(vb_ + voff0 + 256); sv3 = *(const bf16x8*)(vb_ + voff1 + 256); } while (0)
#define ELOADK(kt) do { const char* kb_ = (const char*)Kh + (size_t)(kt) * (64 * LDK * 2); sk0 = *(const bf16x8*)(kb_ + koff0); sk1 = *(const bf16x8*)(kb_ + koff1); } while (0)
#define EWRITEV(b) do { char* d_ = V_lds + (b) * D16_V; *(bf16x8*)(d_ + vst0) = sv0; *(bf16x8*)(d_ + vst1) = sv1; *(bf16x8*)(d_ + 8 * VP16 + vst0) = sv2; *(bf16x8*)(d_ + 8 * VP16 + vst1) = sv3; } while (0)
#define EWRITEK(b) do { char* d_ = K_lds + (b) * PB_K; *(bf16x8*)(d_ + KSWZ(sr, sc * 2)) = sk0; *(bf16x8*)(d_ + KSWZ(32 + sr, sc * 2)) = sk1; } while (0)
#define EQK(kbuf) do { const char* kp_ = K_lds + (kbuf) * PB_K + kb0; \
    s[0][0] = f32x4a{0.f, 0.f, 0.f, 0.f}; s[0][1] = s[0][0]; s[1][0] = s[0][0]; s[1][1] = s[0][0]; \
    _Pragma("unroll") for (int ds = 0; ds < 4; ++ds) { \
      _Pragma("unroll") for (int kt = 0; kt < 2; ++kt) { const bf16x8 a_ = *reinterpret_cast<const bf16x8*>(kp_ + kt * (16 * 272) + ds * 64); \
        s[kt][0] = MFMA16(a_, qr[0][ds], s[kt][0]); s[kt][1] = MFMA16(a_, qr[1][ds], s[kt][1]); } } } while (0)
#define ESM(par) do { \
    _Pragma("unroll") for (int kt = 0; kt < 2; ++kt) { _Pragma("unroll") for (int qt = 0; qt < 2; ++qt) { _Pragma("unroll") for (int i = 0; i < 4; ++i) s[kt][qt][i] = __builtin_amdgcn_exp2f(fmaf(s[kt][qt][i], C, mnC)); } } \
    ls0 += ((s[0][0][0] + s[0][0][1]) + (s[0][0][2] + s[0][0][3])) + ((s[1][0][0] + s[1][0][1]) + (s[1][0][2] + s[1][0][3])); \
    ls1 += ((s[0][1][0] + s[0][1][1]) + (s[0][1][2] + s[0][1][3])) + ((s[1][1][0] + s[1][1][1]) + (s[1][1][2] + s[1][1][3])); \
    _Pragma("unroll") for (int qt = 0; qt < 2; ++qt) { \
      u32x4 w_ = {cvtpk(s[0][qt][0], s[0][qt][1]), cvtpk(s[0][qt][2], s[0][qt][3]), cvtpk(s[1][qt][0], s[1][qt][1]), cvtpk(s[1][qt][2], s[1][qt][3])}; po[qt] = *reinterpret_cast<bf16x8*>(&w_); } \
    { char* d_ = P_own + (par) * (4 * PB_P); *(bf16x8*)(d_) = po[0]; *(bf16x8*)(d_ + 1024) = po[1]; } } while (0)
  const int NT = seq / KVBLK;
#pragma unroll 1
  for (int pass = 0; pass < 2; ++pass) {
  const bf16* Kh = Kh0 + pass * 128;
  float ls0 = 0.f, ls1 = 0.f; f32x4a o[8][2] = {}; bf16x8 qr[2][4]; f32x4a s[2][2]; bf16x8 po[2];
  { int l16q = l16, gq = g, widq = wid; asm volatile("" : "+v"(l16q), "+v"(gq), "+v"(widq));
    const bf16* Qw = Qb0 + pass * 128 + (long)((widq & 3) * QBLK + l16q) * LDQ + gq * 8;
#pragma unroll
    for (int qt = 0; qt < 2; ++qt)
#pragma unroll
      for (int ds = 0; ds < 4; ++ds) qr[qt][ds] = *reinterpret_cast<const bf16x8*>(Qw + (long)qt * 16 * LDQ + ds * 32); }
  ELOADK(0); ELOADV(0); asm volatile("s_waitcnt vmcnt(0)" ::: "memory"); EWRITEK(0); EWRITEV(0);
  ELOADK(1); asm volatile("s_waitcnt vmcnt(0)" ::: "memory"); EWRITEK(1); __syncthreads();
  ELOADK(2); ELOADV(1);
  EQK(0); ESM(0);
  if (wid >= 4) __builtin_amdgcn_s_setprio(1);
  for (int t = 0; t < NT; ++t) {
    __syncthreads();
    bf16x8 pp[2]; { const char* d_ = P_oth + (t & 1) * (4 * PB_P); pp[0] = *(const bf16x8*)(d_); pp[1] = *(const bf16x8*)(d_ + 1024); }
    const bf16x8 pc[2] = {po[0], po[1]};
    const bool more = t + 1 < NT;
    if (more) EQK((t + 1) & 1);
    const int vb = vlane + (t & 1) * (int)D16_V, vbo = vb + ch * 1024, vbp = vb + (1 - ch) * 1024;
    SBAR(); pv16d<0>(o, vbo, vbp, pc, pp); SBAR();
    asm volatile("s_waitcnt vmcnt(0)" ::: "memory");
    if (t + 2 < NT) EWRITEK(t & 1);
    if (t + 1 < NT) EWRITEV((t + 1) & 1);
    ELOADK(t + 3); ELOADV(t + 2);
    SBAR(); pv16d<4>(o, vbo, vbp, pc, pp); SBAR();
    if (more) ESM((t + 1) & 1);
  }
  __builtin_amdgcn_s_setprio(0);
  ls0 += __shfl_xor(ls0, 16); ls0 += __shfl_xor(ls0, 32); ls1 += __shfl_xor(ls1, 16); ls1 += __shfl_xor(ls1, 32);
  __syncthreads();
  int l16e = l16, ge = g, wide = wid; asm volatile("" : "+v"(l16e), "+v"(ge), "+v"(wide));
  const int rbe = wide & 3, che = wide >> 2;
  if (ge == 0) { L_lds[wide * 32 + l16e] = ls0; L_lds[wide * 32 + 16 + l16e] = ls1; }
  __syncthreads();
  float rl[2];
#pragma unroll
  for (int qt = 0; qt < 2; ++qt) rl[qt] = __builtin_amdgcn_rcpf(L_lds[rbe * 32 + 16 * qt + l16e] + L_lds[(rbe + 4) * 32 + 16 * qt + l16e]);
  float* rowp = Ob + (long)(rbe * QBLK + l16e) * LDO + che * 128 + 4 * ge;
  if (pass == 0) {
#pragma unroll
    for (int qt = 0; qt < 2; ++qt) { float* pq = rowp + (long)qt * 16 * LDO; asm volatile("" : "+v"(pq));
#pragma unroll
      for (int dt = 0; dt < 8; ++dt) *reinterpret_cast<f32x4a*>(pq + dt * 16) = o[dt][qt] * rl[qt]; }
  } else {
    float ssq[2];
#pragma unroll
    for (int qt = 0; qt < 2; ++qt) { const float* pq = rowp + (long)qt * 16 * LDO; asm volatile("" : "+v"(pq)); float q_ = 0.f;
#pragma unroll
      for (int dt = 0; dt < 8; ++dt) { const f32x4a v = *reinterpret_cast<const f32x4a*>(pq + dt * 16) - lam * (o[dt][qt] * rl[qt]); o[dt][qt] = v; q_ += (v[0] * v[0] + v[1] * v[1]) + (v[2] * v[2] + v[3] * v[3]); }
      q_ += __shfl_xor(q_, 16); q_ += __shfl_xor(q_, 32); ssq[qt] = q_; }
    if (ge == 0) { S_lds[wide * 32 + l16e] = ssq[0]; S_lds[wide * 32 + 16 + l16e] = ssq[1]; }
    __syncthreads();
    bf16* mrow = Mx + (long)(rbe * QBLK + l16e) * DMX + che * 128 + 4 * ge;
#pragma unroll
    for (int qt = 0; qt < 2; ++qt) { bf16* pm_ = mrow + (long)qt * 16 * DMX; asm volatile("" : "+v"(pm_));
      const int rr = 16 * qt + l16e; const float sc_ = osc / sqrtf((S_lds[rbe * 32 + rr] + S_lds[(rbe + 4) * 32 + rr]) * (1.0f / 256.0f) + 1e-6f);
#pragma unroll
      for (int dt = 0; dt < 8; ++dt) { const f32x4a gv = *reinterpret_cast<const f32x4a*>(sg + che * 128 + dt * 16 + 4 * ge); unsigned u_[4];
#pragma unroll
        for (int i = 0; i < 4; ++i) { const float v = o[dt][qt][i] * sc_ * gv[i]; unsigned u = __float_as_uint(v); u_[i] = (u + 0x7fffu + ((u >> 16) & 1u)) >> 16; }
        u32x2a w_ = {u_[0] | (u_[1] << 16), u_[2] | (u_[3] << 16)};
        *reinterpret_cast<u32x2a*>(pm_ + dt * 16) = w_; } }
  }
  __syncthreads();
  }
#undef ELOADV
#undef ELOADK
#undef EWRITEV
#undef EWRITEK
#undef EQK
#undef ESM
}

#undef KSWZ
#undef SBAR
}

constexpr int DM = 2048, SEQ = 16384, CTXL = 256, NTOK = SEQ + CTXL;
constexpr int EV_IN = 4624, EV_LD = 4608, EV_NP = 4864;
constexpr int FFD = 5632, FFE = 7168, OD_LD = 6144;
constexpr int NCH = 260;
constexpr int MAXROWS = 34816;
constexpr float EPS = 1e-6f;
constexpr float EXGU_SCALE = 32.0f;
constexpr float EXDN_SCALE = 64.0f;
constexpr int NWAVES = 8;
constexpr size_t MiB = 1u << 20;
constexpr size_t WS_CTL = 0, CTL_ZERO_BYTES = 1 * MiB;
constexpr int CW_BAR = 4096, CW_CNT = 8192;
constexpr size_t WS_MOD = 512 * 1024;
constexpr size_t al256(size_t x) { return (x + 255) / 256 * 256; }
constexpr size_t WS_TAB = 1 * MiB;
constexpr size_t WS_G = WS_TAB + 64 * 1024;
constexpr size_t WS_GP = WS_G + al256((size_t)NTOK * 16 * 4);
constexpr size_t WS_GS = WS_GP + al256((size_t)8 * NCH * 192 * 4);
constexpr size_t WS_NS = WS_GS + al256((size_t)8 * NCH * 8 * 4);
constexpr size_t WS_TOK = WS_NS + al256((size_t)8 * NCH * 128 * 4);
constexpr size_t WS_ROW = WS_TOK + al256((size_t)SEQ * 6 * 4);
constexpr size_t WS_XC = al256(WS_ROW + (size_t)MAXROWS * 8);
constexpr size_t WS_W_EVIN = al256(WS_XC + (size_t)CTXL * DM * 4);
constexpr size_t WS_W_EVOUT = WS_W_EVIN + (size_t)EV_NP * DM * 2;
constexpr size_t WS_W_EVGU = WS_W_EVOUT + (size_t)DM * DM * 2;
constexpr size_t WS_W_EVDN = WS_W_EVGU + (size_t)2 * FFD * DM * 2;
constexpr size_t WS_W_ODIN = WS_W_EVDN + (size_t)DM * FFD * 2;
constexpr size_t WS_W_ODOUT = WS_W_ODIN + (size_t)OD_LD * DM * 2;
constexpr size_t WS_W_EXGU = WS_W_ODOUT + (size_t)DM * DM * 2;
constexpr size_t WS_W_EXDN = WS_W_EXGU + (size_t)8 * 2 * FFE * DM * 2;
constexpr size_t WS_H = WS_W_EXDN + (size_t)8 * DM * FFE * 2;
constexpr size_t WS_PROJ = WS_H + (size_t)NTOK * DM * 2;
constexpr size_t WS_MIX = WS_PROJ + (size_t)NTOK * OD_LD * 2;
constexpr size_t WS_BIG = WS_MIX + (size_t)NTOK * DM * 2;
constexpr size_t WS_END = WS_BIG + (size_t)MAXROWS * FFE * 2;
static_assert((size_t)8 * NCH * 32768 * 2 <= (size_t)MAXROWS * FFE * 2 && (size_t)NTOK * FFD * 2 <= (size_t)MAXROWS * FFE * 2 && (size_t)SEQ * 4096 * 4 <= (size_t)MAXROWS * FFE * 2, "overlay");
static_assert((size_t)MAXROWS * DM * 2 <= (size_t)NTOK * OD_LD * 2, "permuted input fits PROJ");
constexpr int RING_BYTES = 139264, MISC_OFF = RING_BYTES + 320, LDS_BYTES = 147456;
static_assert(att::SHM_D16 <= (size_t)RING_BYTES && att::SHM_G16 <= (size_t)RING_BYTES && att::SHM_PAIR <= (size_t)RING_BYTES && att::SHM_ATTN <= (size_t)RING_BYTES && att::SHM_GQA2 + 1024 <= (size_t)RING_BYTES, "attention LDS");

#define LAS __attribute__((address_space(3)))
typedef unsigned short bf16;
typedef short bf16x8 __attribute__((ext_vector_type(8)));
typedef float f32x4 __attribute__((ext_vector_type(4)));
typedef float f32x16 __attribute__((ext_vector_type(16)));
typedef unsigned u32x4 __attribute__((ext_vector_type(4)));
typedef unsigned u32x2 __attribute__((ext_vector_type(2)));
#define LDS_WAIT() asm volatile("s_waitcnt lgkmcnt(0)" ::: "memory")
__device__ __forceinline__ float bf2f(unsigned b) { return __uint_as_float(b << 16); }
__device__ __forceinline__ unsigned f2bf(float f) { unsigned u = __float_as_uint(f); return (u + 0x7fffu + ((u >> 16) & 1u)) >> 16; }
__device__ __forceinline__ unsigned pk2(float lo, float hi) { return pg8::cvt_pk_bf16(lo, hi); }
__device__ __forceinline__ float wave_sum(float v) {
#pragma unroll
    for (int o = 1; o < 64; o <<= 1) v += __shfl_xor(v, o);
    return v;
}
__device__ __forceinline__ float wave_max(float v) {
#pragma unroll
    for (int o = 1; o < 64; o <<= 1) v = fmaxf(v, __shfl_xor(v, o));
    return v;
}

#define XB_TMO      128
#define XB_XCNT(j)  (256  + 64 * (j))
#define XB_XSUB(j)  (1280 + 64 * (j))
#define XB_XGEN(j)  (2304 + 64 * (j))
#define XB_TOP      3328
#define XB_TOPGEN   3392
#define XCD_BAR_WORDS 3456
#define XB_SPIN_CAP (1u << 18)

__device__ __forceinline__ unsigned xb_ld(unsigned* p)              { return __hip_atomic_load(p, __ATOMIC_RELAXED, __HIP_MEMORY_SCOPE_AGENT); }
__device__ __forceinline__ unsigned xb_add(unsigned* p, unsigned v) { return __hip_atomic_fetch_add(p, v, __ATOMIC_RELAXED, __HIP_MEMORY_SCOPE_AGENT); }
__device__ __forceinline__ unsigned xb_xcc_id() { return (unsigned)__builtin_amdgcn_s_getreg((3 << 11) | 20) & 0xFu; }
#define XB_SPIN(cond, bar) do { unsigned _sp = 0; while (cond) { __builtin_amdgcn_s_sleep(1); \
    if ((++_sp & 255u) == 0u) { if (xb_ld(&(bar)[XB_TMO])) break; if (_sp > XB_SPIN_CAP) { atomicAdd(&(bar)[XB_TMO], 1u); break; } } } } while (0)

struct XcdBarrier {
    unsigned* bar; unsigned x;
    volatile LAS unsigned* st;
};

__device__ __forceinline__ XcdBarrier xcd_barrier_post(unsigned* bar, volatile LAS unsigned* st) {
    XcdBarrier b; b.bar = bar; b.x = xb_xcc_id(); b.st = st;
    if (threadIdx.x == 0) (void)xb_add(&bar[XB_XCNT(b.x)], 1u);
    return b;
}
__device__ __forceinline__ void xcd_barrier_complete(unsigned* bar, unsigned x, unsigned& nloc, unsigned& nx) {
    const unsigned G = gridDim.x * gridDim.y * gridDim.z;
    unsigned sum, cnt, mine, sp = 0u;
    for (;;) {
        sum = 0u; cnt = 0u; mine = 0u;
#pragma unroll
        for (unsigned j = 0; j < 16; ++j) { const unsigned c = xb_ld(&bar[XB_XCNT(j)]); sum += c; cnt += (c > 0u) ? 1u : 0u; mine = (j == x) ? c : mine; }
        if (sum == G) break;
        __builtin_amdgcn_s_sleep(1);
        if ((++sp & 255u) == 0u) { if (xb_ld(&bar[XB_TMO])) break; if (sp > XB_SPIN_CAP) { atomicAdd(&bar[XB_TMO], 1u); break; } }
    }
    nloc = mine > 0u ? mine : 1u; nx = cnt > 0u ? cnt : 1u;
}

__device__ __forceinline__ void xcd_barrier(const XcdBarrier& b) {
    asm volatile("s_waitcnt vmcnt(0)" ::: "memory");
    __syncthreads();
    if (threadIdx.x == 0) {
        unsigned* bar = b.bar;
        __builtin_amdgcn_s_waitcnt(0);
        unsigned nloc = b.st[0], nx = b.st[1];
        if (nloc == 0u) { xcd_barrier_complete(bar, b.x, nloc, nx); b.st[0] = nloc; b.st[1] = nx; }
        const unsigned old = xb_add(&bar[XB_XSUB(b.x)], 1u);
        const unsigned gen = old / nloc;
        if (old + 1u == (gen + 1u) * nloc) {
            __builtin_amdgcn_fence(__ATOMIC_RELEASE, "agent");
            asm volatile("s_waitcnt vmcnt(0)" ::: "memory");
            const unsigned og = xb_add(&bar[XB_TOP], 1u);
            const unsigned tg = og / nx;
            if (og + 1u == (tg + 1u) * nx) xb_add(&bar[XB_TOPGEN], 1u);
            else XB_SPIN(xb_ld(&bar[XB_TOPGEN]) == tg, bar);
            __builtin_amdgcn_fence(__ATOMIC_ACQUIRE, "agent");
            xb_add(&bar[XB_XGEN(b.x)], 1u);
            asm volatile("s_waitcnt vmcnt(0)" ::: "memory");
        } else {
            XB_SPIN(xb_ld(&bar[XB_XGEN(b.x)]) == gen, bar);
            __builtin_amdgcn_fence(__ATOMIC_ACQUIRE, "agent");
            asm volatile("s_waitcnt vmcnt(0)" ::: "memory");
        }
    }
    __syncthreads();
}

struct Args { const float* in[28]; float* out; unsigned char* ws; int ph_lo, ph_hi; };
enum { I_X = 0, I_C, I_CTX, I_CCTX, I_ADAW, I_ADAB, I_EVWIN, I_EVGB, I_EVQG, I_EVKG, I_EVHG, I_EVWOUT, I_EVFG, I_EVFU, I_EVFD,
       I_ODWIN, I_ODQG, I_ODKG, I_LQ1, I_LK1, I_LQ2, I_LK2, I_ODSG, I_ODWOUT, I_ROUTER, I_EXG, I_EXU, I_EXD };

__device__ __forceinline__ void transpose_item(const float* W, int ldw, int nvalid, int K, bf16* WT, int mode, int item, int nblk, LAS float* scr, int lane) {
    const int kb = item / nblk, nb = item % nblk, k0 = 64 * kb, n0 = 32 * nb;
    const int kr = lane >> 3, c4 = (lane & 7) * 4; const bool ok = n0 + c4 < nvalid;
#pragma unroll
    for (int i = 0; i < 8; ++i) { const f32x4 x = ok ? *(const f32x4*)(W + (size_t)(k0 + 8 * i + kr) * ldw + n0 + c4) : (f32x4){0.f, 0.f, 0.f, 0.f};
        LAS float* sp = scr + (8 * i + kr) * 33 + c4; sp[0] = x.x; sp[1] = x.y; sp[2] = x.z; sp[3] = x.w; }
    LDS_WAIT(); asm volatile("" ::: "memory");
    const int c = lane & 7;
#pragma unroll
    for (int j = 0; j < 4; ++j) { const int n = (lane >> 3) + 8 * j; const LAS float* s = scr + (8 * c) * 33 + n;
        u32x4 o; o.x = pk2(s[0 * 33], s[1 * 33]); o.y = pk2(s[2 * 33], s[3 * 33]); o.z = pk2(s[4 * 33], s[5 * 33]); o.w = pk2(s[6 * 33], s[7 * 33]);
        const int ns = n0 + n; const int dr = mode == 0 ? ns : (256 * (ns >> 7) + 128 * (mode - 1) + (ns & 127));
        *(u32x4*)(WT + (size_t)dr * K + k0 + 8 * c) = o; }
    LDS_WAIT(); asm volatile("" ::: "memory");
}
__device__ __forceinline__ void transpose_item_fp8(const float* W, int ldw, int K, unsigned char* WT8, float scale, int mode, int item, int nblk, LAS float* scr, int lane) {
    const int kb = item / nblk, nb = item % nblk, k0 = 128 * kb, n0 = 32 * nb;
    const int kr = lane >> 3, c4 = (lane & 7) * 4;
#pragma unroll
    for (int i = 0; i < 16; ++i) { const f32x4 x = *(const f32x4*)(W + (size_t)(k0 + 8 * i + kr) * ldw + n0 + c4) * scale;
        LAS float* sp = scr + (8 * i + kr) * 33 + c4; sp[0] = x.x; sp[1] = x.y; sp[2] = x.z; sp[3] = x.w; }
    LDS_WAIT(); asm volatile("" ::: "memory");
    const int c = lane & 7;
#pragma unroll
    for (int j = 0; j < 4; ++j) { const int n = (lane >> 3) + 8 * j; const LAS float* sp = scr + (16 * c) * 33 + n;
        u32x4 o; o.x = pg8::pk4_fp8(sp[0 * 33], sp[1 * 33], sp[2 * 33], sp[3 * 33]); o.y = pg8::pk4_fp8(sp[4 * 33], sp[5 * 33], sp[6 * 33], sp[7 * 33]);
        o.z = pg8::pk4_fp8(sp[8 * 33], sp[9 * 33], sp[10 * 33], sp[11 * 33]); o.w = pg8::pk4_fp8(sp[12 * 33], sp[13 * 33], sp[14 * 33], sp[15 * 33]);
        const int ns = n0 + n; const int dr = mode == 0 ? ns : (256 * (ns >> 7) + 128 * (mode - 1) + (ns & 127));
        *(u32x4*)(WT8 + (size_t)dr * K + k0 + 16 * c) = o; }
    LDS_WAIT(); asm volatile("" ::: "memory");
}
__device__ __forceinline__ float silu_h(float x) { return x / (1.0f + expf(-x)); }
__device__ __forceinline__ void p0_prologue(const Args& a, LAS unsigned char* lds, int tid, int lane, int wave, int bid, int G) {
    unsigned char* ws = a.ws;
    LAS float* scr = (LAS float*)(lds + wave * 16896);
    const int gw = bid * NWAVES + wave, NGW = G * NWAVES;
    constexpr int J1 = 32 * (EV_NP / 32), J2 = 32 * 64, J3 = 32 * (FFD / 32), J4 = (FFD / 64) * 64, J5 = 32 * (OD_LD / 32), J6 = 32 * 64, J7 = 8 * (DM / 128) * (FFE / 32), J8 = 8 * (FFE / 128) * 64;
    constexpr int NITEMS = J1 + J2 + 2 * J3 + J4 + J5 + J6 + 2 * J7 + J8;
    { float* MOD = (float*)(ws + WS_MOD); LAS float* sv = (LAS float*)lds; LAS float* part = sv + 4096;
      for (int k = tid; k < DM; k += 512) { sv[k] = silu_h(a.in[I_C][k]); sv[DM + k] = silu_h(a.in[I_CCTX][k]); }
      __syncthreads();
      for (int it = bid; it < 192; it += G) {
          const int l = it / 96, cb = it % 96, col = cb * 128 + (lane & 31) * 4, kr = lane >> 5;
          f32x4 ac = {0.f, 0.f, 0.f, 0.f}, ax = {0.f, 0.f, 0.f, 0.f};
          const float* wp = a.in[I_ADAW] + ((size_t)l * DM + wave * 256 + kr) * 12288 + col;
#pragma unroll 8
          for (int i = 0; i < 128; ++i) { const f32x4 wv = *(const f32x4*)(wp + (size_t)(2 * i) * 12288); const int k = wave * 256 + 2 * i + kr; ac += wv * sv[k]; ax += wv * sv[DM + k]; }
          const int pi = (wave * 2 + kr) * 2;
          *(LAS f32x4*)(part + (pi + 0) * 128 + (lane & 31) * 4) = ac; *(LAS f32x4*)(part + (pi + 1) * 128 + (lane & 31) * 4) = ax;
          __syncthreads();
          if (tid < 256) { const int kind = tid >> 7, cr = tid & 127; float sum = a.in[I_ADAB][l * 12288 + cb * 128 + cr];
#pragma unroll
              for (int q = 0; q < 16; ++q) sum += part[(q * 2 + kind) * 128 + cr];
              MOD[(l * 2 + kind) * 12288 + cb * 128 + cr] = sum; }
          __syncthreads();
      }
    }
    for (int it = gw; it < NITEMS; it += NGW) {
        int r = it;
        if (r < J1) { transpose_item(a.in[I_EVWIN], EV_IN, EV_IN, DM, (bf16*)(ws + WS_W_EVIN), 0, r, EV_NP / 32, scr, lane); continue; } r -= J1;
        if (r < J2) { transpose_item(a.in[I_EVWOUT], DM, DM, DM, (bf16*)(ws + WS_W_EVOUT), 0, r, 64, scr, lane); continue; } r -= J2;
        if (r < J3) { transpose_item(a.in[I_EVFG], FFD, FFD, DM, (bf16*)(ws + WS_W_EVGU), 1, r, FFD / 32, scr, lane); continue; } r -= J3;
        if (r < J3) { transpose_item(a.in[I_EVFU], FFD, FFD, DM, (bf16*)(ws + WS_W_EVGU), 2, r, FFD / 32, scr, lane); continue; } r -= J3;
        if (r < J4) { transpose_item(a.in[I_EVFD], DM, DM, FFD, (bf16*)(ws + WS_W_EVDN), 0, r, 64, scr, lane); continue; } r -= J4;
        if (r < J5) { transpose_item(a.in[I_ODWIN], OD_LD, OD_LD, DM, (bf16*)(ws + WS_W_ODIN), 0, r, OD_LD / 32, scr, lane); continue; } r -= J5;
        if (r < J6) { transpose_item(a.in[I_ODWOUT], DM, DM, DM, (bf16*)(ws + WS_W_ODOUT), 0, r, 64, scr, lane); continue; } r -= J6;
        if (r < J7) { const int e = r / (J7 / 8), rr = r % (J7 / 8); transpose_item_fp8(a.in[I_EXG] + (size_t)e * DM * FFE, FFE, DM, (unsigned char*)(ws + WS_W_EXGU) + (size_t)e * 2 * FFE * DM, EXGU_SCALE, 1, rr, FFE / 32, scr, lane); continue; } r -= J7;
        if (r < J7) { const int e = r / (J7 / 8), rr = r % (J7 / 8); transpose_item_fp8(a.in[I_EXU] + (size_t)e * DM * FFE, FFE, DM, (unsigned char*)(ws + WS_W_EXGU) + (size_t)e * 2 * FFE * DM, EXGU_SCALE, 2, rr, FFE / 32, scr, lane); continue; } r -= J7;
        { const int e = r / (J8 / 8), rr = r % (J8 / 8); transpose_item_fp8(a.in[I_EXD] + (size_t)e * FFE * DM, DM, FFE, (unsigned char*)(ws + WS_W_EXDN) + (size_t)e * DM * FFE, EXDN_SCALE, 0, rr, 64, scr, lane); }
    }
    { const int g = bid * 512 + tid;
      if (g < 8192) { const int pos = g >> 5, f = g & 31; const float inv = exp2f(-(float)f * (13.287712379549449f / 32.0f)); const float ang = (float)pos * inv;
          double rev = (double)ang * 0.15915494309189535; rev -= floor(rev); const float rf = (float)rev;
          float* T = (float*)(ws + WS_TAB); T[2 * g] = __builtin_amdgcn_cosf(rf); T[2 * g + 1] = __builtin_amdgcn_sinf(rf); } }
}

template <bool ROUTER>
__device__ __forceinline__ void phase_norm(const Args& a, LAS unsigned char* lds, int tid, int lane, int wave, int bid, int G,
                                           const float* src_lat, const float* src_ctx, int nrows, int layer, int which, const float* part, int nparts, float* ctx_wb) {
    unsigned char* ws = a.ws; bf16* H = (bf16*)(ws + WS_H); const float* MOD = (const float*)(ws + WS_MOD) + layer * 2 * 12288;
    LAS float* RT = (LAS float*)lds;
    LAS unsigned* lcnt = (LAS unsigned*)(lds + 65536); LAS unsigned* lgb = lcnt + 8; LAS unsigned* lpair = lcnt + 16;
    if (ROUTER) { int tidr = tid; asm volatile("" : "+v"(tidr));     for (int idx = tidr; idx < DM * 8; idx += 512) { RT[(idx & 7) * DM + (idx >> 3)] = a.in[I_ROUTER][idx]; } if (tid < 8) lcnt[tid] = 0u; __syncthreads(); }
    const int gw = bid * NWAVES + wave, NGW = G * NWAVES;
    for (int row = gw; row < nrows; row += NGW) {
        const bool isc = row >= SEQ;
        const f32x4* xr = (const f32x4*)(isc ? src_ctx + (size_t)(row - SEQ) * DM : src_lat + (size_t)row * DM) + lane;
        const f32x4* sh = (const f32x4*)(MOD + (isc ? 12288 : 0) + which * 3 * DM) + lane; const f32x4* sc = sh + DM / 4;
        f32x4 v[8]; float ss = 0.f;
#pragma unroll
        for (int j = 0; j < 8; ++j) v[j] = xr[64 * j];
        if (isc && nparts > 0) {
            for (int p = 0; p < nparts; ++p) { const f32x4* pr = (const f32x4*)(part + ((size_t)p * 256 + (row - SEQ)) * DM) + lane;
#pragma unroll
                for (int j = 0; j < 8; ++j) v[j] += pr[64 * j]; }
            if (ctx_wb) { f32x4* wb = (f32x4*)(ctx_wb + (size_t)(row - SEQ) * DM) + lane;
#pragma unroll
                for (int j = 0; j < 8; ++j) wb[64 * j] = v[j]; }
        }
#pragma unroll
        for (int j = 0; j < 8; ++j) ss += (v[j].x * v[j].x + v[j].y * v[j].y) + (v[j].z * v[j].z + v[j].w * v[j].w);
        const float rstd = 1.0f / sqrtf(wave_sum(ss) * (1.0f / DM) + EPS);
        float lg[8];
        if (ROUTER) {
#pragma unroll
            for (int e = 0; e < 8; ++e) lg[e] = 0.f; }
        u32x2* o8 = (u32x2*)(H + (size_t)row * DM) + lane;
#pragma unroll
        for (int j = 0; j < 8; ++j) { const f32x4 s4 = sc[64 * j], h4 = sh[64 * j]; const f32x4 hv = v[j] * rstd * (s4 + 1.0f) + h4;
            u32x2 w; w.x = pk2(hv.x, hv.y); w.y = pk2(hv.z, hv.w); o8[64 * j] = w; v[j] = hv; }
        if (ROUTER) {
#pragma unroll
            for (int e = 0; e < 8; ++e) { float s = 0.f;
#pragma unroll
                for (int j = 0; j < 8; ++j) { const f32x4 rt = *(const LAS f32x4*)(RT + e * DM + 256 * j + 4 * lane); s += (v[j].x * rt.x + v[j].y * rt.y) + (v[j].z * rt.z + v[j].w * rt.w); }
                lg[e] = s; asm volatile("" ::: "memory"); } }
        if (ROUTER) {
#pragma unroll
            for (int e = 0; e < 8; ++e) lg[e] = wave_sum(lg[e]);
            if (lane == 0) {
                int e0 = 0; float v0 = lg[0];
#pragma unroll
                for (int e = 1; e < 8; ++e) if (lg[e] > v0) { v0 = lg[e]; e0 = e; }
                int e1 = -1; float v1 = -3.0e38f;
#pragma unroll
                for (int e = 0; e < 8; ++e) if (e != e0 && lg[e] > v1) { v1 = lg[e]; e1 = e; }
                const float w0 = 1.0f / (1.0f + expf(v1 - v0)), w1 = 1.0f - w0;
                const unsigned s0 = __hip_atomic_fetch_add(lcnt + e0, 1u, __ATOMIC_RELAXED, __HIP_MEMORY_SCOPE_WORKGROUP), s1 = __hip_atomic_fetch_add(lcnt + e1, 1u, __ATOMIC_RELAXED, __HIP_MEMORY_SCOPE_WORKGROUP);
                const int li = ((row - gw) / NGW) * NWAVES + wave; LAS unsigned* lp = lpair + li * 4; lp[0] = (unsigned)e0; lp[1] = (unsigned)e1; lp[2] = s0; lp[3] = s1;
                unsigned* tk = (unsigned*)(ws + WS_TOK) + (size_t)row * 6;
                tk[0] = (unsigned)e0; tk[1] = (unsigned)e1; tk[4] = __float_as_uint(w0); tk[5] = __float_as_uint(w1);
            }
        }
    }
    if (ROUTER) {
        __syncthreads();
        if (tid < 8) lgb[tid] = __hip_atomic_fetch_add((unsigned*)(ws + WS_CTL) + CW_CNT + tid, lcnt[tid], __ATOMIC_RELAXED, __HIP_MEMORY_SCOPE_AGENT);
        __syncthreads();
        const int nloc = (nrows - bid * NWAVES + NGW - 1) / NGW;
        if (tid < nloc * NWAVES) { const int w_ = tid % NWAVES, i_ = tid / NWAVES, row = bid * NWAVES + w_ + i_ * NGW;
            if (row < nrows) { const LAS unsigned* lp = lpair + tid * 4; unsigned* tk = (unsigned*)(ws + WS_TOK) + (size_t)row * 6; tk[2] = lgb[lp[0]] + lp[2]; tk[3] = lgb[lp[1]] + lp[3]; } }
    }
}

__device__ __forceinline__ int seq_row(int dir, int c, int pos) { return dir == 0 ? (c < 4 ? SEQ + 64 * c + pos : 64 * (c - 4) + pos) : (c < 4 ? SEQ + 255 - 64 * c - pos : SEQ - 1 - 64 * (c - 4) - pos); }
__device__ __forceinline__ int blk_row(int dir, int c) { return dir == 0 ? (c < 4 ? SEQ + 64 * c : 64 * (c - 4)) : (c < 4 ? SEQ + 64 * (3 - c) : 64 * (259 - c)); }
template <int NQ, int NK, bool CTXQ, bool GATES, bool CTXSLAB = false>
__device__ __forceinline__ void phase_qknorm(const Args& a, int lane, int wave, int bid, int G, int ld, int qcol0, int kcol0, const float* qg, const float* kg) {
    unsigned char* ws = a.ws; bf16* P = (bf16*)(ws + WS_PROJ); const float* TAB = (const float*)(ws + WS_TAB);
    const int gw = bid * NWAVES + wave, NGW = G * NWAVES;
    if (GATES) {
        const float* Gt = (const float*)(ws + WS_G); float* GP = (float*)(ws + WS_GP); float* GSC = (float*)(ws + WS_GS) + 8 * NCH * 4;
        for (int it = gw; it < 8 * NCH; it += NGW) {
            const int dh = it / NCH, c = it % NCH, dir = dh >> 2, head = dh & 3;
            const int row = seq_row(dir, c, lane);
            const float gi = Gt[(size_t)row * 16 + dir * 8 + head], gf = Gt[(size_t)row * 16 + dir * 8 + 4 + head];
            const float fc = fminf(gf, 0.f) - log1pf(expf(-fabsf(gf)));
            float bc = fc;
#pragma unroll
            for (int o = 1; o < 64; o <<= 1) { const float t = __shfl_up(bc, o); if (lane >= o) bc += t; }
            const float av = gi - bc; float pm = av;
#pragma unroll
            for (int o = 1; o < 64; o <<= 1) { const float t = __shfl_up(pm, o); if (lane >= o) pm = fmaxf(pm, t); }
            float* gp = GP + (size_t)it * 192; gp[lane] = av; gp[64 + lane] = pm; gp[128 + lane] = bc;
            const float blast = __shfl(bc, 63), pml = __shfl(pm, 63);
            if (lane == 0) { GSC[it * 2] = blast; GSC[it * 2 + 1] = blast + pml; }
        }
    }
    const float q0 = qg[2 * lane], q1 = qg[2 * lane + 1], k0 = kg[2 * lane], k1 = kg[2 * lane + 1];
    for (int t = gw; t < NTOK; t += NGW) {
        const bool lat = t < SEQ; unsigned* base = (unsigned*)(P + (size_t)t * ld) + lane;
        if (CTXSLAB && !lat) {
            typedef float f2_ __attribute__((ext_vector_type(2)));
            const f2_* sl = (const f2_*)((const float*)(ws + WS_BIG) + (size_t)(t - SEQ) * 4096) + lane;
#pragma unroll 1
            for (int i0 = 0; i0 < 32; i0 += 4) {
                f2_ v[4][8];
#pragma unroll
                for (int i = 0; i < 4; ++i)
#pragma unroll
                    for (int sb = 0; sb < 8; ++sb) v[i][sb] = sl[(size_t)sb * (256 * 4096 / 2) + (i0 + i) * 64];
#pragma unroll
                for (int i = 0; i < 4; ++i) { const f2_ x = ((v[i][0] + v[i][1]) + (v[i][2] + v[i][3])) + ((v[i][4] + v[i][5]) + (v[i][6] + v[i][7]));
                    if (i0 < 16) { const float rstd = 1.0f / sqrtf(wave_sum(x[0] * x[0] + x[1] * x[1]) * (1.0f / 128.0f) + EPS);
                        base[(kcol0 + (i0 + i) * 128) >> 1] = pk2(x[0] * rstd * k0, x[1] * rstd * k1); }
                    else base[(kcol0 + (i0 + i) * 128) >> 1] = pk2(x[0], x[1]); } }
            continue;
        }
        float c = 1.f, s = 0.f;
        if (lat) { const int pos = lane < 32 ? (t >> 6) : (t & 63); const float* tp = TAB + 2 * (pos * 32 + (lane & 31)); c = tp[0]; s = tp[1]; }
        const bool doq = lat || CTXQ;
        unsigned uq[NQ], uk[NK];
        if (doq) {
#pragma unroll
            for (int i = 0; i < NQ; ++i) uq[i] = base[(qcol0 + i * 128) >> 1]; }
#pragma unroll
        for (int i = 0; i < NK; ++i) uk[i] = base[(kcol0 + i * 128) >> 1];
        if (doq) {
#pragma unroll
            for (int i = 0; i < NQ; ++i) { const float x0 = bf2f(uq[i] & 0xffffu), x1 = bf2f(uq[i] >> 16);
                const float rstd = 1.0f / sqrtf(wave_sum(x0 * x0 + x1 * x1) * (1.0f / 128.0f) + EPS); const float y0 = x0 * rstd * q0, y1 = x1 * rstd * q1;
                base[(qcol0 + i * 128) >> 1] = pk2(y0 * c - y1 * s, y0 * s + y1 * c); } }
#pragma unroll
        for (int i = 0; i < NK; ++i) { const float x0 = bf2f(uk[i] & 0xffffu), x1 = bf2f(uk[i] >> 16);
            const float rstd = 1.0f / sqrtf(wave_sum(x0 * x0 + x1 * x1) * (1.0f / 128.0f) + EPS); const float y0 = x0 * rstd * k0, y1 = x1 * rstd * k1;
            base[(kcol0 + i * 128) >> 1] = pk2(y0 * c - y1 * s, y0 * s + y1 * c); }
    }
}

__device__ __forceinline__ unsigned bfelem(const u32x4& u, int e) { const unsigned w = u[e >> 1]; return (e & 1) ? (w >> 16) : (w & 0xffffu); }
__device__ __forceinline__ void phase_m3(const Args& a, LAS unsigned char* lds, int tid, int lane, int wave, int bid, int G) {
    unsigned char* ws = a.ws; const bf16* P = (const bf16*)(ws + WS_PROJ); const float* GP = (const float*)(ws + WS_GP); const float* GS = (const float*)(ws + WS_GS);
    float* NS = (float*)(ws + WS_NS); bf16* ST = (bf16*)(ws + WS_BIG);
    LAS bf16* KwT = (LAS bf16*)lds; LAS bf16* VT = (LAS bf16*)(lds + 18432); LAS float* wts = (LAS float*)(lds + 18432 + 36864);
    const int l31 = lane & 31, hi = lane >> 5;
    LAS float* gsc = (LAS float*)(lds + 65536); LAS float* gsl = gsc + 8 * NCH * 2;
    { const float* GSC = GS + 8 * NCH * 4; for (int i = tid; i < 8 * NCH * 2; i += 512) gsc[i] = GSC[i]; }
    __syncthreads();
    if (lane == 0) { const int dh = wave; float m = -1e30f;
        for (int c = 0; c < NCH; ++c) { const float b = gsc[(dh * NCH + c) * 2], mn = fmaxf(b + m, gsc[(dh * NCH + c) * 2 + 1]); LAS float* g = gsl + (dh * NCH + c) * 4; g[0] = m; g[1] = mn; g[2] = expf(b + m - mn); g[3] = b; m = mn; } }
    __syncthreads();
    if (bid == 0) { float* GSw = (float*)(ws + WS_GS); for (int i = tid; i < 8 * NCH * 4; i += 512) GSw[i] = gsl[i]; }
    for (int it = bid; it < 8 * NCH; it += G) {
        const int dh = it / NCH, c = it % NCH, dir = dh >> 2, head = dh & 3, r0 = blk_row(dir, c);
        __syncthreads();
        if (tid < 64) { const int pos = dir ? 63 - tid : tid; const float* gp = GP + (size_t)(dh * NCH + c) * 192; const LAS float* gs = gsl + (dh * NCH + c) * 4; wts[tid] = expf(gs[3] + gp[pos] - gs[1]); }
        __syncthreads();
        { const int row = tid >> 3, cc = (tid & 7) * 16; const bf16* src = P + (size_t)(r0 + row) * EV_LD + 2048 + head * 128 + cc;
          const u32x4 u0 = *(const u32x4*)src, u1 = *(const u32x4*)(src + 8); const float w = wts[row];
#pragma unroll
          for (int e = 0; e < 8; ++e) { KwT[(cc + e) * 72 + row] = (bf16)f2bf(w * bf2f(bfelem(u0, e))); KwT[(cc + 8 + e) * 72 + row] = (bf16)f2bf(w * bf2f(bfelem(u1, e))); } }
        { const int row = tid >> 3, cc = (tid & 7) * 32; const bf16* src = P + (size_t)(r0 + row) * EV_LD + 2560 + head * 256 + cc;
#pragma unroll
          for (int q = 0; q < 4; ++q) { const u32x4 u = *(const u32x4*)(src + 8 * q);
#pragma unroll
              for (int e = 0; e < 8; ++e) VT[(cc + 8 * q + e) * 72 + row] = (bf16)bfelem(u, e); } }
        __syncthreads();
        f32x16 acc[4];
#pragma unroll
        for (int dt = 0; dt < 4; ++dt)
#pragma unroll
            for (int r = 0; r < 16; ++r) acc[dt][r] = 0.f;
#pragma unroll
        for (int ks = 0; ks < 4; ++ks) { const bf16x8 bfr = *(const LAS bf16x8*)(VT + (wave * 32 + l31) * 72 + ks * 16 + 8 * hi);
#pragma unroll
            for (int dt = 0; dt < 4; ++dt) { const bf16x8 afr = *(const LAS bf16x8*)(KwT + (dt * 32 + l31) * 72 + ks * 16 + 8 * hi);
                acc[dt] = __builtin_amdgcn_mfma_f32_32x32x16_bf16(afr, bfr, acc[dt], 0, 0, 0); } }
        bf16* dst = ST + (size_t)(dh * NCH + c) * 32768 + (size_t)(wave * 32 + l31) * 128;
#pragma unroll
        for (int dt = 0; dt < 4; ++dt)
#pragma unroll
            for (int g = 0; g < 4; ++g) { u32x2 w; w.x = pk2(acc[dt][4 * g], acc[dt][4 * g + 1]); w.y = pk2(acc[dt][4 * g + 2], acc[dt][4 * g + 3]); *(u32x2*)(dst + dt * 32 + 8 * g + 4 * hi) = w; }
        if (tid < 128) { float s = 0.f;
#pragma unroll 8
            for (int q = 0; q < 64; ++q) s += bf2f(KwT[tid * 72 + q]);
            NS[(size_t)(dh * NCH + c) * 128 + tid] = s; }
    }
}
__device__ __forceinline__ void phase_m4(const Args& a, int tid, int bid, int G) {
    unsigned char* ws = a.ws; const float* GS = (const float*)(ws + WS_GS); float* NS = (float*)(ws + WS_NS); unsigned* ST = (unsigned*)(ws + WS_BIG);
    constexpr int NU = 20;
    for (int q = bid; q < 256; q += G) {
        const int dh = q >> 5; unsigned* base = ST + (size_t)dh * NCH * 16384 + (q & 31) * 512 + tid; const float* gs = GS + (size_t)dh * NCH * 4 + 2;
        float c0 = 0.f, c1 = 0.f;
#pragma unroll 1
        for (int c = 0; c < NCH; c += NU) { unsigned u[NU]; float ad[NU];
#pragma unroll
            for (int i = 0; i < NU; ++i) { u[i] = base[(size_t)(c + i) * 16384]; ad[i] = gs[(c + i) * 4]; }
#pragma unroll
            for (int i = 0; i < NU; ++i) { base[(size_t)(c + i) * 16384] = pk2(c0, c1); c0 = ad[i] * c0 + bf2f(u[i] & 0xffffu); c1 = ad[i] * c1 + bf2f(u[i] >> 16); } }
    }
    for (int p = bid * 512 + tid; p < 8 * 128; p += G * 512) {
        const int dh = p >> 7; float* base = NS + (size_t)dh * NCH * 128 + (p & 127); const float* gs = GS + (size_t)dh * NCH * 4 + 2; float n = 0.f;
#pragma unroll 1
        for (int c = 0; c < NCH; c += NU) { float d[NU], ad[NU];
#pragma unroll
            for (int i = 0; i < NU; ++i) { d[i] = base[(size_t)(c + i) * 128]; ad[i] = gs[(c + i) * 4]; }
#pragma unroll
            for (int i = 0; i < NU; ++i) { base[(size_t)(c + i) * 128] = n; n = ad[i] * n + d[i]; } }
    }
}
__device__ __forceinline__ void phase_m5(const Args& a, LAS unsigned char* lds, int tid, int lane, int wave, int bid, int G) {
    size_t vz = 0; asm volatile("" : "+v"(vz));
    unsigned char* ws = a.ws; const bf16* P = (const bf16*)(ws + WS_PROJ); const float* GP = (const float*)(ws + WS_GP + vz); const float* GS = (const float*)(ws + WS_GS + vz);
    const float* NS = (const float*)(ws + WS_NS + vz); const bf16* ST = (const bf16*)(ws + WS_BIG + vz); bf16* MIX = (bf16*)(ws + WS_MIX + vz);
    constexpr float SC = 0.088388347648318440f;
    LAS bf16* Qs = (LAS bf16*)lds; LAS bf16* Ks = (LAS bf16*)(lds + 17408); LAS bf16* VT = (LAS bf16*)(lds + 34816); LAS float* Hs = (LAS float*)lds;
    LAS bf16* Ps = (LAS bf16*)(lds + 71680); LAS float* arr = (LAS float*)(lds + 80896);
    const int l31 = lane & 31, hi = lane >> 5;
    for (int it = bid; it < 4 * NCH; it += G) {
        const int head = it / NCH, b = it % NCH, r0 = b < 256 ? 64 * b : SEQ + 64 * (b - 256);
        __syncthreads();
        { const int row = tid >> 3, cc = (tid & 7) * 16; const bf16* sq = P + (size_t)(r0 + row) * EV_LD + 1536 + head * 128 + cc; const bf16* sk = sq + 512;
          *(LAS u32x4*)(Qs + row * 136 + cc) = *(const u32x4*)sq; *(LAS u32x4*)(Qs + row * 136 + cc + 8) = *(const u32x4*)(sq + 8);
          *(LAS u32x4*)(Ks + row * 136 + cc) = *(const u32x4*)sk; *(LAS u32x4*)(Ks + row * 136 + cc + 8) = *(const u32x4*)(sk + 8); }
        { const int row = tid >> 3, cc = (tid & 7) * 32; const bf16* src = P + (size_t)(r0 + row) * EV_LD + 2560 + head * 256 + cc;
#pragma unroll
          for (int q = 0; q < 4; ++q) { const u32x4 u = *(const u32x4*)(src + 8 * q);
#pragma unroll
              for (int e = 0; e < 8; ++e) VT[(cc + 8 * q + e) * 72 + row] = (bf16)bfelem(u, e); } }
        f32x16 hsum[2];
#pragma unroll
        for (int rt = 0; rt < 2; ++rt)
#pragma unroll
            for (int r = 0; r < 16; ++r) hsum[rt][r] = 0.f;
#pragma unroll 1
        for (int dir = 0; dir < 2; ++dir) {
            const int c = dir == 0 ? (b < 256 ? 4 + b : b - 256) : (b < 256 ? 259 - b : 3 - (b - 256)); const int dh = dir * 4 + head;
            if (tid < 64) { const int pos = dir ? 63 - tid : tid; const float* gp = GP + (size_t)(dh * NCH + c) * 192; const float ms = GS[(size_t)(dh * NCH + c) * 4];
                const float av = gp[pos], pmv = gp[64 + pos], bc = gp[128 + pos], M = fmaxf(ms, pmv);
                arr[tid] = av; arr[64 + tid] = M; arr[128 + tid] = expf(ms - M); arr[192 + tid] = expf(-bc - M); }
            else if (tid < 192) arr[384 + tid - 64] = NS[(size_t)(dh * NCH + c) * 128 + tid - 64];
            __syncthreads();
            const bf16* ctp = ST + (size_t)(dh * NCH + c) * 32768 + (size_t)(wave * 32 + l31) * 128 + 8 * hi;
            bf16x8 ctf[8];
#pragma unroll
            for (int ks = 0; ks < 8; ++ks) ctf[ks] = *(const bf16x8*)(ctp + 16 * ks);
            if (wave < 4) { const int rt = wave >> 1, ct = wave & 1; f32x16 s;
#pragma unroll
                for (int r = 0; r < 16; ++r) s[r] = 0.f;
#pragma unroll
                for (int ks = 0; ks < 8; ++ks) { const bf16x8 af = *(const LAS bf16x8*)(Qs + (rt * 32 + l31) * 136 + 16 * ks + 8 * hi), bfr = *(const LAS bf16x8*)(Ks + (ct * 32 + l31) * 136 + 16 * ks + 8 * hi);
                    s = __builtin_amdgcn_mfma_f32_32x32x16_bf16(af, bfr, s, 0, 0, 0); }
                const int sidx = ct * 32 + l31; const float as = arr[sidx];
#pragma unroll
                for (int r = 0; r < 16; ++r) { const int j = rt * 32 + (r & 3) + 8 * (r >> 2) + 4 * hi; const bool valid = dir ? (sidx >= j) : (sidx <= j);
                    const float p = valid ? s[r] * SC * expf(as - arr[64 + j]) : 0.f; Ps[j * 72 + sidx] = (bf16)f2bf(p); }
            } else if (wave == 4) { float qn = 0.f;
#pragma unroll 8
                for (int d = 0; d < 128; ++d) qn += bf2f(Qs[lane * 136 + d]) * arr[384 + d];
                arr[256 + lane] = qn * SC; }
            __syncthreads();
            f32x16 inter[2], intra[2];
#pragma unroll
            for (int rt = 0; rt < 2; ++rt)
#pragma unroll
                for (int r = 0; r < 16; ++r) { inter[rt][r] = 0.f; intra[rt][r] = 0.f; }
#pragma unroll
            for (int rt = 0; rt < 2; ++rt)
#pragma unroll
                for (int ks = 0; ks < 8; ++ks) { const bf16x8 af = *(const LAS bf16x8*)(Qs + (rt * 32 + l31) * 136 + 16 * ks + 8 * hi); inter[rt] = __builtin_amdgcn_mfma_f32_32x32x16_bf16(af, ctf[ks], inter[rt], 0, 0, 0); }
#pragma unroll
            for (int ks = 0; ks < 4; ++ks) { const bf16x8 bfr = *(const LAS bf16x8*)(VT + (wave * 32 + l31) * 72 + 16 * ks + 8 * hi);
#pragma unroll
                for (int rt = 0; rt < 2; ++rt) { const bf16x8 af = *(const LAS bf16x8*)(Ps + (rt * 32 + l31) * 72 + 16 * ks + 8 * hi); intra[rt] = __builtin_amdgcn_mfma_f32_32x32x16_bf16(af, bfr, intra[rt], 0, 0, 0); } }
            if (wave == 0) { float rs = 0.f;
#pragma unroll 8
                for (int q = 0; q < 64; ++q) rs += bf2f(Ps[lane * 72 + q]);
                const float den = arr[128 + lane] * arr[256 + lane] + rs; arr[320 + lane] = 1.0f / fmaxf(fabsf(den), arr[192 + lane]); }
            __syncthreads();
#pragma unroll
            for (int rt = 0; rt < 2; ++rt)
#pragma unroll
                for (int r = 0; r < 16; ++r) { const int j = rt * 32 + (r & 3) + 8 * (r >> 2) + 4 * hi; hsum[rt][r] += (arr[128 + j] * SC * inter[rt][r] + intra[rt][r]) * arr[320 + j]; }
            __syncthreads();
        }
#pragma unroll
        for (int rt = 0; rt < 2; ++rt)
#pragma unroll
            for (int r = 0; r < 16; ++r) Hs[(rt * 32 + (r & 3) + 8 * (r >> 2) + 4 * hi) * 260 + wave * 32 + l31] = hsum[rt][r];
        __syncthreads();
        { const int j = tid >> 3, cg = tid & 7; float v[32]; float ss = 0.f;
#pragma unroll
          for (int q = 0; q < 8; ++q) { const f32x4 t = *(const LAS f32x4*)(Hs + j * 260 + cg * 32 + 4 * q); v[4 * q] = t.x; v[4 * q + 1] = t.y; v[4 * q + 2] = t.z; v[4 * q + 3] = t.w; ss += (t.x * t.x + t.y * t.y) + (t.z * t.z + t.w * t.w); }
          ss += __shfl_xor(ss, 1); ss += __shfl_xor(ss, 2); ss += __shfl_xor(ss, 4);
          const float rstd = 1.0f / sqrtf(ss * (1.0f / 256.0f) + EPS);
          const bf16* op = P + (size_t)(r0 + j) * EV_LD + 3584 + head * 256 + cg * 32; const float* hg = (const float*)((const unsigned char*)a.in[I_EVHG] + vz) + head * 256 + cg * 32;
          bf16* mp = MIX + (size_t)(r0 + j) * DM + 1024 + head * 256 + cg * 32;
#pragma unroll
          for (int q = 0; q < 4; ++q) { const u32x4 ou = *(const u32x4*)(op + 8 * q); float o[8];
#pragma unroll
              for (int e = 0; e < 8; ++e) { const float og = bf2f(bfelem(ou, e)); o[e] = v[8 * q + e] * rstd * hg[8 * q + e] / (1.0f + expf(-og)); }
              u32x4 w; w.x = pk2(o[0], o[1]); w.y = pk2(o[2], o[3]); w.z = pk2(o[4], o[5]); w.w = pk2(o[6], o[7]); *(u32x4*)(mp + 8 * q) = w; } }
    }
}

__device__ __forceinline__ void phase_combine(const Args& a, int lane, int wave, int bid, int G) {
    unsigned char* ws = a.ws; const float* O1 = (const float*)(ws + WS_BIG); bf16* MIX = (bf16*)(ws + WS_MIX);
    const float lam_init = 0.8f - 0.6f * expf(-0.3f);
    const float d1 = wave_sum(a.in[I_LQ1][lane] * a.in[I_LK1][lane] + a.in[I_LQ1][64 + lane] * a.in[I_LK1][64 + lane]);
    const float d2 = wave_sum(a.in[I_LQ2][lane] * a.in[I_LK2][lane] + a.in[I_LQ2][64 + lane] * a.in[I_LK2][64 + lane]);
    const float lam = expf(d1) - expf(d2) + lam_init;
    const f32x4 sg = *(const f32x4*)(a.in[I_ODSG] + 4 * lane);
    const int gw = bid * NWAVES + wave, NGW = G * NWAVES;
    for (int it = gw; it < SEQ * 8; it += NGW) {
        const int t = it >> 3, h = it & 7; const f32x4* p = (const f32x4*)(O1 + (size_t)t * 4096 + h * 512) + lane;
        const f32x4 o0 = p[0], o1 = p[64]; const f32x4 v = o0 - o1 * lam;
        const float ss = wave_sum((v.x * v.x + v.y * v.y) + (v.z * v.z + v.w * v.w));
        const float r = (1.0f - lam_init) / sqrtf(ss * (1.0f / 256.0f) + EPS);
        const f32x4 y = v * r * sg; u32x2 w; w.x = pk2(y.x, y.y); w.y = pk2(y.z, y.w);
        *((u32x2*)(MIX + (size_t)t * DM + h * 256) + lane) = w;
    }
}
__device__ __forceinline__ void phase_gather(const Args& a, int lane, int wave, int bid, int G) {
    unsigned char* ws = a.ws; const bf16* H = (const bf16*)(ws + WS_H); unsigned char* HP = (unsigned char*)(ws + WS_PROJ);
    const unsigned* cnt = (const unsigned*)(ws + WS_CTL) + CW_CNT; const unsigned* TK = (const unsigned*)(ws + WS_TOK); unsigned* RW = (unsigned*)(ws + WS_ROW);
    unsigned base[8], cn[8]; { unsigned acc = 0;
#pragma unroll
        for (int e = 0; e < 8; ++e) { cn[e] = cnt[e]; base[e] = acc; acc += ((cn[e] + 255u) >> 8) << 8; } }
    const int gw = bid * NWAVES + wave, NGW = G * NWAVES;
    for (int t = gw; t < SEQ; t += NGW) {
        const unsigned* tk = TK + (size_t)t * 6; const u32x4* src = (const u32x4*)(H + (size_t)t * DM) + lane;
        u32x2 v[4];
#pragma unroll
        for (int j = 0; j < 4; ++j) { const u32x4 x = src[64 * j];
            v[j].x = pg8::pk4_fp8(bf2f(x.x & 0xffffu), bf2f(x.x >> 16), bf2f(x.y & 0xffffu), bf2f(x.y >> 16)); v[j].y = pg8::pk4_fp8(bf2f(x.z & 0xffffu), bf2f(x.z >> 16), bf2f(x.w & 0xffffu), bf2f(x.w >> 16)); }
#pragma unroll
        for (int k = 0; k < 2; ++k) { const unsigned e = tk[k], slot = tk[2 + k]; unsigned b = 0;
#pragma unroll
            for (int q = 0; q < 8; ++q) b = (e == (unsigned)q) ? base[q] : b;
            const unsigned dest = b + slot; u32x2* dp = (u32x2*)(HP + (size_t)dest * DM) + lane;
#pragma unroll
            for (int j = 0; j < 4; ++j) dp[64 * j] = v[j];
            if (lane == 0) { RW[2 * dest] = (unsigned)t; RW[2 * dest + 1] = tk[4 + k]; } }
    }
    for (int it = gw; it < 8 * 256; it += NGW) { const int e = it >> 8, pi = it & 255; unsigned b = 0, c = 0;
#pragma unroll
        for (int q = 0; q < 8; ++q) { b = (e == q) ? base[q] : b; c = (e == q) ? cn[q] : c; }
        const unsigned npad = (((c + 255u) >> 8) << 8) - c;
        if ((unsigned)pi < npad) { const unsigned dest = b + c + pi; u32x2* dp = (u32x2*)(HP + (size_t)dest * DM) + lane; const u32x2 z = {0u, 0u};
#pragma unroll
            for (int j = 0; j < 4; ++j) dp[64 * j] = z;
            if (lane == 0) { RW[2 * dest] = 0xffffffffu; RW[2 * dest + 1] = 0u; } }
    }
}

__device__ __forceinline__ void phase_moe_combine(const Args& a, int lane, int wave, int bid, int G) {
    unsigned char* ws = a.ws; const bf16* YP = (const bf16*)(ws + WS_PROJ); const float* SLAB = (const float*)(ws + WS_H); float* OUT = a.out; const float* g2 = (const float*)(ws + WS_MOD) + 2 * 12288 + 5 * DM;
    const unsigned* cnt = (const unsigned*)(ws + WS_CTL) + CW_CNT; const unsigned* TK = (const unsigned*)(ws + WS_TOK);
    unsigned base[8]; unsigned acc = 0; {
#pragma unroll
        for (int e = 0; e < 8; ++e) { base[e] = acc; acc += ((cnt[e] + 255u) >> 8) << 8; } }
    int pm_split, S; pg8::tail_split((int)(acc >> 8), DM / 256, G, FFE / 128, pm_split, S); const int rt = (int)(acc >> 8) - pm_split;
    f32x4 gg[8];
#pragma unroll
    for (int j = 0; j < 8; ++j) gg[j] = *((const f32x4*)g2 + 64 * j + lane);
    const int gw = bid * NWAVES + wave, NGW = G * NWAVES;
    for (int t = gw; t < SEQ; t += NGW) {
        const unsigned* tk = TK + (size_t)t * 6; unsigned b0 = 0, b1 = 0;
#pragma unroll
        for (int q = 0; q < 8; ++q) { b0 = (tk[0] == (unsigned)q) ? base[q] : b0; b1 = (tk[1] == (unsigned)q) ? base[q] : b1; }
        const float w0 = __uint_as_float(tk[4]), w1 = __uint_as_float(tk[5]);
        f32x4* op = (f32x4*)(OUT + (size_t)t * DM) + lane;
        f32x4 y[8];
#pragma unroll
        for (int j = 0; j < 8; ++j) y[j] = (f32x4){0.f, 0.f, 0.f, 0.f};
#pragma unroll
        for (int k = 0; k < 2; ++k) { const unsigned row = (k ? b1 : b0) + tk[2 + k]; const float w = k ? w1 : w0;
            if ((int)(row >> 8) >= pm_split) {
                const unsigned rl = row - (unsigned)pm_split * 256u;
                for (int sidx = 0; sidx < S; ++sidx) { const f32x4* sp = (const f32x4*)(SLAB + ((size_t)sidx * rt * 256 + rl) * DM) + lane;
#pragma unroll
                    for (int j = 0; j < 8; ++j) y[j] += sp[64 * j] * w; }
            } else { const u32x2* yp = (const u32x2*)(YP + (size_t)row * DM) + lane; u32x2 av[8];
#pragma unroll
                for (int j = 0; j < 8; ++j) av[j] = yp[64 * j];
#pragma unroll
                for (int j = 0; j < 8; ++j) { y[j].x += w * bf2f(av[j].x & 0xffffu); y[j].y += w * bf2f(av[j].x >> 16); y[j].z += w * bf2f(av[j].y & 0xffffu); y[j].w += w * bf2f(av[j].y >> 16); } } }
#pragma unroll
        for (int j = 0; j < 8; ++j) op[64 * j] = op[64 * j] + gg[j] * y[j];
    }
}

constexpr int NPH = 23;
__global__ void __launch_bounds__(NWAVES * 64, 2) __attribute__((amdgpu_num_vgpr(248))) mega_fwd(Args args) {
    extern __shared__ __attribute__((aligned(16))) unsigned char lds_raw[];
    LAS unsigned char* lds = (LAS unsigned char*)lds_raw;
    typedef const Args __attribute__((address_space(4))) CArgs;
#define LA() CArgs* ap_ = (CArgs*)__builtin_amdgcn_kernarg_segment_ptr(); asm volatile("" : "+s"(ap_)); Args la; _Pragma("unroll") for (int i_ = 0; i_ < 28; ++i_) la.in[i_] = ap_->in[i_]; la.out = ap_->out; la.ws = ap_->ws; la.ph_lo = 0; la.ph_hi = 0; \
    const int tid = threadIdx.x, lane = tid & 63, wave = __builtin_amdgcn_readfirstlane(tid >> 6), bid = blockIdx.x, G = gridDim.x; (void)lane; (void)wave; (void)bid; (void)G; \
    unsigned char* const ws = la.ws; float* const OUT = la.out; float* const XC = (float*)(ws + WS_XC); const float* const MOD = (const float*)(ws + WS_MOD); \
    bf16* const H = (bf16*)(ws + WS_H); bf16* const PROJ = (bf16*)(ws + WS_PROJ); bf16* const MIX = (bf16*)(ws + WS_MIX); (void)OUT; (void)XC; (void)MOD; (void)H; (void)PROJ; (void)MIX;
    { const int tid0 = threadIdx.x; for (int u = tid0; u < (LDS_BYTES - RING_BYTES) / 4; u += NWAVES * 64) ((LAS unsigned*)(lds + RING_BYTES))[u] = 0u; }
    __syncthreads();
#if MK_MULTI
#define GRID_BAR() do { } while (0)
    const int lo = args.ph_lo, hi = args.ph_hi;
#else
    { CArgs* ap0 = (CArgs*)__builtin_amdgcn_kernarg_segment_ptr(); (void)xcd_barrier_post((unsigned*)(ap0->ws + WS_CTL) + CW_BAR, (volatile LAS unsigned*)(lds + MISC_OFF) + 8); }
#define GRID_BAR() do { CArgs* apb_ = (CArgs*)__builtin_amdgcn_kernarg_segment_ptr(); asm volatile("" : "+s"(apb_)); XcdBarrier b_; b_.bar = (unsigned*)(apb_->ws + WS_CTL) + CW_BAR; b_.x = xb_xcc_id(); \
        b_.st = (volatile LAS unsigned*)(lds + MISC_OFF) + 8; xcd_barrier(b_); } while (0)
    const int lo = args.ph_lo, hi = args.ph_hi;
#endif
#ifndef PHMASK
#define PHMASK 0xffffffffu
#endif
#define IN(k) (((PHMASK >> (k)) & 1u) && lo <= (k) && (k) < hi)
#ifndef REPEAT_MASK
#define REPEAT_MASK 0u
#endif
#define REP(k) (((REPEAT_MASK >> (k)) & 1u) ? 2 : 1)
#define SEAM(k) do { if (IN(k) && IN((k) + 1)) GRID_BAR(); } while (0)

    if (IN(0)) for (int rep_ = 0; rep_ < REP(0); ++rep_) { if (rep_) GRID_BAR(); LA(); p0_prologue(la, lds, tid, lane, wave, bid, G); } SEAM(0);
    if (IN(1)) { LA(); phase_norm<false>(la, lds, tid, lane, wave, bid, G, la.in[I_X], la.in[I_CTX], NTOK, 0, 0, nullptr, 0, nullptr); } SEAM(1);
    if (IN(2)) for (int rep_ = 0; rep_ < REP(2); ++rep_) { if (rep_) GRID_BAR(); LA(); pg8::Gemm g{H, (const bf16*)(ws + WS_W_EVIN), NTOK, EV_NP, DM}; pg8::StaticOrder S; S.init(NTOK, EV_NP, G, bid);
        pg8::EpiProj<18> E{PROJ, EV_LD, (float*)(ws + WS_G), la.in[I_EVGB]};
        pg8::gemm_phase<pg8::EpiProj<18>, pg8::StaticOrder, true, true>(lds, g, S, E); } SEAM(2);
    if (IN(3)) { LA(); phase_qknorm<8, 2, true, true>(la, lane, wave, bid, G, EV_LD, 0, 1024, la.in[I_EVQG], la.in[I_EVKG]); } SEAM(3);
    if (IN(4)) for (int rep_ = 0; rep_ < REP(4); ++rep_) { if (rep_) GRID_BAR(); LA(); phase_m3(la, lds, tid, lane, wave, bid, G); } SEAM(4);
    if (IN(5)) { LA(); phase_m4(la, tid, bid, G); } SEAM(5);
    if (IN(6)) for (int rep_ = 0; rep_ < REP(6); ++rep_) { if (rep_) GRID_BAR(); LA(); phase_m5(la, lds, tid, lane, wave, bid, G); } SEAM(6);
    if (IN(7)) for (int rep_ = 0; rep_ < REP(7); ++rep_) { if (rep_) GRID_BAR(); LA();
        const float mraw = 128.0f * wave_max(fmaxf(fabsf(la.in[I_EVQG][lane]), fabsf(la.in[I_EVQG][64 + lane]))) * wave_max(fmaxf(fabsf(la.in[I_EVKG][lane]), fabsf(la.in[I_EVKG][64 + lane])));
        const bool fixm = 2.0f * mraw * att::SCALE < 80.0f;
#define ATT0_ITEMS(FX, MR) for (int it = bid; it < 520; it += G) { __syncthreads(); const bf16 *q, *k, *v; bf16* o; int seq; \
            if (it < 512) { const int hq = it >> 6, qb = it & 63, kv = hq >> 2; q = PROJ + (size_t)qb * 256 * EV_LD + hq * 128; k = PROJ + 1024 + kv * 128; v = PROJ + 1280 + kv * 128; o = MIX + (size_t)qb * 256 * DM + hq * 128; seq = NTOK; } \
            else { const int hq = it - 512, kv = hq >> 2; const bf16* pc = PROJ + (size_t)SEQ * EV_LD; q = pc + hq * 128; k = pc + 1024 + kv * 128; v = pc + 1280 + kv * 128; o = MIX + (size_t)SEQ * DM + hq * 128; seq = CTXL; } \
            att::attn_dense_body<EV_LD, EV_LD, DM, true, 2>(q, k, v, o, seq, (char*)lds_raw, FX, MR); }
        if (fixm) {
            for (int it = bid; it < 520; it += G) { __syncthreads();
                if (it < 512) { const int gp = it >> 7, qb = it & 127, g = gp >> 1, hq = 4 * g + 2 * (gp & 1);
                    att::attn_gqa16_body<EV_LD, EV_LD, DM>(PROJ + (size_t)qb * 128 * EV_LD + hq * 128, PROJ + 1024 + g * 128, PROJ + 1280 + g * 128, MIX + (size_t)qb * 128 * DM + hq * 128, NTOK, (char*)lds_raw, mraw); }
                else { const int j = it - 512, gp = j >> 1, qb = j & 1, g = gp >> 1, hq = 4 * g + 2 * (gp & 1); const bf16* pc = PROJ + (size_t)SEQ * EV_LD;
                    att::attn_gqa16_body<EV_LD, EV_LD, DM>(pc + (size_t)qb * 128 * EV_LD + hq * 128, pc + 1024 + g * 128, pc + 1280 + g * 128, MIX + (size_t)(SEQ + qb * 128) * DM + hq * 128, CTXL, (char*)lds_raw, mraw); } }
        } else { ATT0_ITEMS(false, 0.f)
        } } SEAM(7);
    if (IN(8)) { LA(); pg8::Gemm g{MIX, (const bf16*)(ws + WS_W_EVOUT), NTOK, DM, DM}; pg8::CtxSplitOrder S{G, bid, DM / 256, 8, DM / 64};
        pg8::EpiResid E{la.in[I_X], OUT, MOD + 2 * DM, la.in[I_CTX], XC, MOD + 12288 + 2 * DM, (float*)(ws + WS_PROJ), DM / 64};
        pg8::gemm_phase<pg8::EpiResid, pg8::CtxSplitOrder, true, true>(lds, g, S, E); } SEAM(8);
    if (IN(9)) { LA(); phase_norm<false>(la, lds, tid, lane, wave, bid, G, OUT, la.in[I_CTX], NTOK, 0, 1, (const float*)(ws + WS_PROJ), 8, XC); } SEAM(9);
    if (IN(10)) for (int rep_ = 0; rep_ < REP(10); ++rep_) { if (rep_) GRID_BAR(); LA(); pg8::Gemm g{H, (const bf16*)(ws + WS_W_EVGU), NTOK, 2 * FFD, DM}; pg8::StaticOrder S; S.init(NTOK, 2 * FFD, G, bid);
        pg8::EpiSwiGlu<0> E{(bf16*)(ws + WS_BIG), FFD, 1.0f};
        pg8::gemm_phase<pg8::EpiSwiGlu<0>, pg8::StaticOrder, true, true>(lds, g, S, E); } SEAM(10);
    if (IN(11)) { LA(); pg8::Gemm g{(const bf16*)(ws + WS_BIG), (const bf16*)(ws + WS_W_EVDN), NTOK, DM, FFD}; pg8::CtxSplitOrder S{G, bid, DM / 256, 11, FFD / 64};
        pg8::EpiResid E{OUT, OUT, MOD + 5 * DM, XC, XC, MOD + 12288 + 5 * DM, (float*)(ws + WS_PROJ + 32 * MiB), FFD / 64};
        pg8::gemm_phase<pg8::EpiResid, pg8::CtxSplitOrder, true, true>(lds, g, S, E); } SEAM(11);
    if (IN(12)) { LA(); phase_norm<false>(la, lds, tid, lane, wave, bid, G, OUT, XC, NTOK, 1, 0, (const float*)(ws + WS_PROJ + 32 * MiB), 11, nullptr); } SEAM(12);
    if (IN(13)) { LA(); pg8::Gemm g{H, (const bf16*)(ws + WS_W_ODIN), NTOK, OD_LD, DM}; pg8::OdInOrder S{G, bid};
        pg8::EpiProjSplit E{PROJ, OD_LD, (float*)(ws + WS_BIG), DM / 64};
        pg8::gemm_phase<pg8::EpiProjSplit, pg8::OdInOrder, true, true>(lds, g, S, E); } SEAM(13);
    if (IN(14)) { LA(); phase_qknorm<16, 16, false, false, true>(la, lane, wave, bid, G, OD_LD, 0, 2048, la.in[I_ODQG], la.in[I_ODKG]); } SEAM(14);
#define P15_FIXM() const float mraw = 128.0f * wave_max(fmaxf(fabsf(la.in[I_ODQG][lane]), fabsf(la.in[I_ODQG][64 + lane]))) * wave_max(fmaxf(fabsf(la.in[I_ODKG][lane]), fabsf(la.in[I_ODKG][64 + lane]))); \
        const bool fixm = 2.0f * mraw * att::SCALE < 80.0f; float* O1 = (float*)(ws + WS_BIG);
    if (IN(15)) for (int rep_ = 0; rep_ < REP(15); ++rep_) { if (rep_) GRID_BAR(); LA(); P15_FIXM();
        if (fixm) {
            const float lam_init = 0.8f - 0.6f * expf(-0.3f);
            const float d1 = wave_sum(la.in[I_LQ1][lane] * la.in[I_LK1][lane] + la.in[I_LQ1][64 + lane] * la.in[I_LK1][64 + lane]);
            const float d2 = wave_sum(la.in[I_LQ2][lane] * la.in[I_LK2][lane] + la.in[I_LQ2][64 + lane] * la.in[I_LK2][64 + lane]);
            const float lam = expf(d1) - expf(d2) + lam_init;
            for (int it = bid; it < 1024; it += G) { __syncthreads(); const int h = it >> 7, qb = it & 127;
                att::attn_diff16_body<OD_LD, OD_LD, OD_LD, 4096, DM>(PROJ + (size_t)qb * 128 * OD_LD + h * 256, PROJ + 2048 + h * 256, PROJ + 4096 + h * 256,
                                                                O1 + (size_t)qb * 128 * 4096 + h * 512, MIX + (size_t)qb * 128 * DM + h * 256, NTOK, (char*)lds_raw, mraw, lam, 1.0f - lam_init, la.in[I_ODSG]); } }
        else { for (int it = bid; it < 2048; it += G) { __syncthreads(); const int vh = it >> 6, qb = it & 63, h = vh >> 2, r = (vh >> 1) & 1, c = vh & 1;
            att::attn_dense_body<OD_LD, OD_LD, 4096, false, 1>(PROJ + (size_t)qb * 256 * OD_LD + h * 256 + r * 128, PROJ + 2048 + h * 256 + r * 128, PROJ + 4096 + h * 256 + c * 128,
                                                                O1 + (size_t)qb * 256 * 4096 + (h * 2 + r) * 256 + c * 128, NTOK, (char*)lds_raw, false, 0.f); } } }
    SEAM(15);
    if (IN(16)) { LA(); P15_FIXM(); (void)O1; if (!fixm) phase_combine(la, lane, wave, bid, G); } SEAM(16);
    if (IN(17)) { LA(); pg8::Gemm g{MIX, (const bf16*)(ws + WS_W_ODOUT), SEQ, DM, DM}; pg8::StaticOrder S; S.init(SEQ, DM, G, bid);
        pg8::EpiResid E{OUT, OUT, MOD + 2 * 12288 + 2 * DM, XC, XC, MOD + 3 * 12288 + 2 * DM, nullptr, DM / 64};
        pg8::gemm_phase<pg8::EpiResid, pg8::StaticOrder, true, true>(lds, g, S, E); } SEAM(17);
    if (IN(18)) { LA(); phase_norm<true>(la, lds, tid, lane, wave, bid, G, OUT, XC, SEQ, 1, 1, nullptr, 0, nullptr); } SEAM(18);
    if (IN(19)) { LA(); phase_gather(la, lane, wave, bid, G); } SEAM(19);
    if (IN(20)) for (int rep_ = 0; rep_ < REP(20); ++rep_) { if (rep_) GRID_BAR(); LA(); pg8::Gemm g{PROJ, (const bf16*)(ws + WS_W_EXGU), MAXROWS, 8 * 2 * FFE, DM / 2}; pg8::GroupedOrder S; S.init((const unsigned*)(ws + WS_CTL) + CW_CNT, 2 * FFE / 256, G, bid);
        pg8::EpiSwiGlu<2 * FFE / 256, true> E{(bf16*)(ws + WS_BIG), FFE, 1.0f / EXGU_SCALE};
        pg8::gemm_phase<pg8::EpiSwiGlu<2 * FFE / 256, true>, pg8::GroupedOrder, true, true, true>(lds, g, S, E); } SEAM(20);
    if (IN(21)) { LA(); pg8::Gemm g{(const bf16*)(ws + WS_BIG), (const bf16*)(ws + WS_W_EXDN), MAXROWS, 8 * DM, FFE / 2}; pg8::GroupedOrder S; S.init((const unsigned*)(ws + WS_CTL) + CW_CNT, DM / 256, G, bid, FFE / 128);
        pg8::EpiMoeDown E{PROJ, (float*)(ws + WS_H), S.pm_split, S.nM - S.pm_split, FFE / 128, 1.0f / EXDN_SCALE};
        pg8::gemm_phase<pg8::EpiMoeDown, pg8::GroupedOrder, true, true, true>(lds, g, S, E); } SEAM(21);
    if (IN(22)) { LA(); phase_moe_combine(la, lane, wave, bid, G); }
#undef IN
#undef SEAM
}


extern "C" void kernel_launch(void* const* d_in, const int* in_sizes, int n_in, void* d_out, int out_size, void* d_ws, size_t ws_size, hipStream_t stream) {
    static int grid = 0;
    if (grid == 0) {
        if (n_in != 28 || out_size != SEQ * DM || ws_size < WS_END) { fprintf(stderr, "kernel_launch: unexpected shapes: n_in %d out %d ws %zu (need %zu)\n", n_in, out_size, ws_size, (size_t)WS_END); grid = -1; return; }
        int dev = 0, cus = 0, per_cu = 0;
        if (hipGetDevice(&dev) != hipSuccess || hipDeviceGetAttribute(&cus, hipDeviceAttributeMultiprocessorCount, dev) != hipSuccess) { grid = -1; return; }
        if (hipFuncSetAttribute((const void*)mega_fwd, hipFuncAttributeMaxDynamicSharedMemorySize, LDS_BYTES) != hipSuccess) { fprintf(stderr, "kernel_launch: hipFuncSetAttribute failed\n"); grid = -1; return; }
        if (hipOccupancyMaxActiveBlocksPerMultiprocessor(&per_cu, (const void*)mega_fwd, NWAVES * 64, LDS_BYTES) != hipSuccess || per_cu < 1) { fprintf(stderr, "kernel_launch: occupancy query reports %d\n", per_cu); }
        (void)hipGetLastError();
        grid = cus;
    }
    if (grid < 0) return;
    (void)hipMemsetAsync((char*)d_ws + WS_CTL, 0, CTL_ZERO_BYTES, stream);
    Args a{};
    for (int i = 0; i < 28; ++i) a.in[i] = (const float*)d_in[i];
    a.out = (float*)d_out; a.ws = (unsigned char*)d_ws;
#if MK_MULTI
    for (int k = 0; k < NPH; ++k) { a.ph_lo = k; a.ph_hi = k + 1; hipLaunchKernelGGL(mega_fwd, dim3(grid), dim3(NWAVES * 64), LDS_BYTES, stream, a); }
#else
    a.ph_lo = 0; a.ph_hi = NPH; hipLaunchKernelGGL(mega_fwd, dim3(grid), dim3(NWAVES * 64), LDS_BYTES, stream, a);
#endif
    const hipError_t le = hipPeekAtLastError();
    if (le != hipSuccess) fprintf(stderr, "kernel_launch: launch failed: %s\n", hipGetErrorName(le));
}
```

```cpp
#include <hip/hip_runtime.h>
#include <cstdio>
#include <cstdint>
#ifndef MK_MULTI
#define MK_MULTI 0
#endif
namespace pg8 {
#define PG8_LAS __attribute__((address_space(3)))
typedef unsigned short bf16_t;
typedef short bf16x8 __attribute__((ext_vector_type(8)));
typedef float f32x4 __attribute__((ext_vector_type(4)));
typedef unsigned u32x4 __attribute__((ext_vector_type(4)));
constexpr int BM = 256, BK = 64, HALF = 128, HTB = HALF * BK * 2  , STAGE_BYTES = 8 * HTB, NXCD = 8, WGM = 8;

__host__ __device__ __forceinline__ int lds_byte(int r, int c) { const int st = (r >> 4) * 2 + (c >> 5), rr = r & 15, cc = c & 31, ob = rr * 64 + cc * 2; return st * 1024 + (ob ^ (((ob >> 9) & 1) << 5)); }
__host__ __device__ __forceinline__ void stage_rc(int b, int& R, int& C) { const int st = b / 1024, sb = b % 1024, swz = sb ^ (((sb >> 9) & 1) << 5); R = (st >> 1) * 16 + swz / 64; C = (st & 1) * 32 + (swz % 64) / 2; }
__host__ __device__ __forceinline__ int perm32(int rho) { const int n = rho >> 4, i = rho & 15; return 8 * (i >> 2) + 4 * n + (i & 3); }

struct Unit { int pm, pn, kt0, ntk; };
struct Gemm { const bf16_t* A; const bf16_t* Bt; int M, N, K; };

struct StaticOrder {
    int nM, nN, nwg, G, c;
    __host__ __device__ void init(int M, int N, int G_, int c_) { nM = M / BM; nN = N / BM; nwg = nM * nN; G = G_; c = c_; }
    __host__ __device__ bool next(int i, Unit& u) const {
        const long L = (long)i * G + c; if (L >= nwg) return false;
        int wgid = (int)L; { const int q = nwg / NXCD, r = nwg % NXCD, xcd = wgid % NXCD, off = wgid / NXCD; wgid = (xcd < r ? xcd * (q + 1) : r * (q + 1) + (xcd - r) * q) + off; }
        const int nig = WGM * nN, gid = wgid / nig, fm = gid * WGM, gsz = (nM - fm) < WGM ? (nM - fm) : WGM;
        u.pm = fm + ((wgid % nig) % gsz); u.pn = (wgid % nig) / gsz; return true;
    }
    __device__ __forceinline__ void a_ready(const Unit&) const {}
    __device__ __forceinline__ void done(const Unit&) const {}
};

typedef float f32x2c __attribute__((ext_vector_type(2)));
typedef __bf16 bf16x2c __attribute__((ext_vector_type(2)));
__device__ __forceinline__ unsigned cvt_pk_bf16(float lo, float hi) { const f32x2c v = {lo, hi}; const bf16x2c b = __builtin_convertvector(v, bf16x2c); return __builtin_bit_cast(unsigned, b); }
typedef float f32x2 __attribute__((ext_vector_type(2)));
__device__ __forceinline__ void static_map(int wgid, int nM, int nN, int& pm, int& pn) {
    const int nwg = nM * nN;
    { const int q = nwg / NXCD, r = nwg % NXCD, xcd = wgid % NXCD, off = wgid / NXCD; wgid = (xcd < r ? xcd * (q + 1) : r * (q + 1) + (xcd - r) * q) + off; }
    const int nig = WGM * nN, gid = wgid / nig, fm = gid * WGM, gsz = (nM - fm) < WGM ? (nM - fm) : WGM;
    pm = fm + ((wgid % nig) % gsz); pn = (wgid % nig) / gsz;
}
struct OdInOrder {
    int G, c;
    __device__ __forceinline__ bool next(int i, Unit& u) const {
        const int L = i * G + c;
        if (L < 64 * 24) { static_map(L, 64, 24, u.pm, u.pn); return true; }
        if (L < 64 * 24 + 16) { u.pm = 64; u.pn = 8 + (L - 64 * 24); return true; }
        return false;
    }
    __device__ __forceinline__ void a_ready(const Unit&) const {}
    __device__ __forceinline__ void done(const Unit&) const {}
};
struct CtxSplitOrder {
    int G, c, nN, S, ntfull;
    __device__ __forceinline__ bool next(int i, Unit& u) const {
        const int L = i * G + c;
        if (L < 64 * nN) { static_map(L, 64, nN, u.pm, u.pn); return true; }
        const int j = L - 64 * nN; if (j >= nN * S) return false;
        u.pm = 64; u.pn = j / S; u.ntk = ntfull / S; u.kt0 = (j % S) * u.ntk; return true;
    }
    __device__ __forceinline__ void a_ready(const Unit&) const {}
    __device__ __forceinline__ void done(const Unit&) const {}
};
__device__ __forceinline__ void tail_split(int nM, int nN, int G, int ntfull, int& pm_split, int& S) {
    const int per = G / nN, rt = (per > 0 && G % nN == 0) ? nM % per : 0; pm_split = nM - rt; S = 1;
    if (rt > 0) { const int cap = G / (rt * nN);
        const int cand[6] = {28, 14, 8, 4, 2, 1};
#pragma unroll
        for (int q = 5; q >= 0; --q) if (cand[q] <= cap && ntfull % (2 * cand[q]) == 0 && ntfull / cand[q] >= 4) S = cand[q]; }
    if (S == 1) pm_split = nM;
}
struct GroupedOrder {
    int nM, nN, G, c; int t1, t2, t3, t4, t5, t6, t7; int pm_split, S, ntfull;
    __device__ __forceinline__ void init(const unsigned* cnt, int nN_, int G_, int c_, int ntfull_ = 0) {
        int t[9]; t[0] = 0;
#pragma unroll
        for (int e = 0; e < 8; ++e) t[e + 1] = t[e] + (int)((cnt[e] + 255u) >> 8);
        t1 = t[1]; t2 = t[2]; t3 = t[3]; t4 = t[4]; t5 = t[5]; t6 = t[6]; t7 = t[7]; nM = t[8]; nN = nN_; G = G_; c = c_; ntfull = ntfull_; pm_split = nM; S = 1;
        if (ntfull_ > 0) tail_split(nM, nN, G, ntfull_, pm_split, S);
    }
    __device__ __forceinline__ bool next(int i, Unit& u) const {
        const int L = i * G + c, nfull = pm_split * nN; int pm, j;
        if (L < nfull) static_map(L, pm_split, nN, pm, j);
        else { const int idx = L - nfull; if (idx >= (nM - pm_split) * nN * S) return false; const int q = idx / S; pm = pm_split + q / nN; j = q % nN; u.ntk = ntfull / S; u.kt0 = (idx % S) * u.ntk; }
        const int e = (pm >= t1) + (pm >= t2) + (pm >= t3) + (pm >= t4) + (pm >= t5) + (pm >= t6) + (pm >= t7);
        u.pm = pm; u.pn = e * nN + j; return true;
    }
    __device__ __forceinline__ void a_ready(const Unit&) const {}
    __device__ __forceinline__ void done(const Unit&) const {}
};

__device__ __forceinline__ float silu_f(float g) { return g * __builtin_amdgcn_rcpf(1.0f + __builtin_amdgcn_exp2f(-1.4426950408889634f * g)); }

template <int GATE_PN> struct EpiProj {
    static constexpr bool PERM = true, AFTER_DRAIN = false;
    bf16_t* O; int ldc; float* G; const float* gate_b;
    __device__ __forceinline__ void operator()(const f32x4 (&acc)[2][2][4][2], const Unit& u, int wr, int wc, int fr, int fq) const {
        const int row0 = u.pm * BM + wr * 64 + fr;
        if (GATE_PN >= 0 && u.pn == GATE_PN) {
            if (wc == 0 && fq < 2) {
#pragma unroll
                for (int ai = 0; ai < 2; ++ai)
#pragma unroll
                    for (int m = 0; m < 4; ++m) { float* gp = G + (size_t)(row0 + ai * HALF + m * 16) * 16 + 8 * fq;
#pragma unroll
                        for (int n = 0; n < 2; ++n) { const f32x4 b = *(const f32x4*)(gate_b + 8 * fq + 4 * n); *(f32x4*)(gp + 4 * n) = acc[ai][0][m][n] + b; } }
            }
            return;
        }
        const int col0 = u.pn * BM + wc * 32 + 8 * fq;
#pragma unroll
        for (int ai = 0; ai < 2; ++ai)
#pragma unroll
            for (int m = 0; m < 4; ++m) { bf16_t* rowp = O + (size_t)(row0 + ai * HALF + m * 16) * ldc + col0;
#pragma unroll
                for (int bj = 0; bj < 2; ++bj) { const f32x4 v0 = acc[ai][bj][m][0], v1 = acc[ai][bj][m][1];
                    u32x4 w; w.x = cvt_pk_bf16(v0[0], v0[1]); w.y = cvt_pk_bf16(v0[2], v0[3]); w.z = cvt_pk_bf16(v1[0], v1[1]); w.w = cvt_pk_bf16(v1[2], v1[3]);
                    *(u32x4*)(rowp + bj * HALF) = w; } }
    }
};
struct EpiResid {
    static constexpr bool PERM = false, AFTER_DRAIN = false;
    const float* in_lat; float* out_lat; const float* g_lat; const float* in_ctx; float* out_ctx; const float* g_ctx; float* part; int ntfull;
    __device__ __forceinline__ void operator()(const f32x4 (&acc)[2][2][4][2], const Unit& u, int wr, int wc, int fr, int fq) const {
        const bool isc = u.pm >= 64; const int pml = isc ? u.pm - 64 : u.pm;
        const float* xin = isc ? in_ctx : in_lat; float* xout = isc ? out_ctx : out_lat; const float* gv = isc ? g_ctx : g_lat;
        const int row0 = pml * BM + wr * 64 + fr, col0 = u.pn * BM + wc * 32 + 4 * fq;
        f32x4 gg[2][2];
#pragma unroll
        for (int bj = 0; bj < 2; ++bj)
#pragma unroll
            for (int n = 0; n < 2; ++n) gg[bj][n] = *(const f32x4*)(gv + col0 + bj * HALF + n * 16);
        if (u.ntk != ntfull) {
            float* pp = part + (size_t)(u.kt0 / u.ntk) * (256 * 2048);
#pragma unroll
            for (int ai = 0; ai < 2; ++ai)
#pragma unroll
                for (int m = 0; m < 4; ++m) { const size_t off = (size_t)(row0 + ai * HALF + m * 16) * 2048 + col0;
#pragma unroll
                    for (int bj = 0; bj < 2; ++bj)
#pragma unroll
                        for (int n = 0; n < 2; ++n) *(f32x4*)(pp + off + bj * HALF + n * 16) = gg[bj][n] * acc[ai][bj][m][n]; }
            return;
        }
#pragma unroll
        for (int ai = 0; ai < 2; ++ai)
#pragma unroll
            for (int m = 0; m < 4; ++m) { const size_t off = (size_t)(row0 + ai * HALF + m * 16) * 2048 + col0;
#pragma unroll
                for (int bj = 0; bj < 2; ++bj)
#pragma unroll
                    for (int n = 0; n < 2; ++n) { const f32x4 xi = *(const f32x4*)(xin + off + bj * HALF + n * 16);
                        *(f32x4*)(xout + off + bj * HALF + n * 16) = xi + gg[bj][n] * acc[ai][bj][m][n]; } }
    }
};
__device__ __forceinline__ unsigned pk4_fp8(float a, float b, float c, float d) { unsigned w = (unsigned)__builtin_amdgcn_cvt_pk_fp8_f32(a, b, 0, false); return (unsigned)__builtin_amdgcn_cvt_pk_fp8_f32(c, d, (int)w, true); }
template <int NTN  , bool FP8OUT = false> struct EpiSwiGlu {
    static constexpr bool PERM = true, AFTER_DRAIN = false;
    bf16_t* O; int ldc; float isc;
    __device__ __forceinline__ void operator()(const f32x4 (&acc)[2][2][4][2], const Unit& u, int wr, int wc, int fr, int fq) const {
        const int pnl = u.pn % (NTN ? NTN : 0x7fffffff);
        const int row0 = u.pm * BM + wr * 64 + fr, hc0 = 128 * pnl + 32 * wc + 8 * fq;
#pragma unroll
        for (int ai = 0; ai < 2; ++ai)
#pragma unroll
            for (int m = 0; m < 4; ++m) {
                const f32x4 g0 = acc[ai][0][m][0] * isc, g1 = acc[ai][0][m][1] * isc, u0 = acc[ai][1][m][0] * isc, u1 = acc[ai][1][m][1] * isc;
                if constexpr (FP8OUT) { unsigned char* rowp = (unsigned char*)O + (size_t)(row0 + ai * HALF + m * 16) * ldc + hc0; typedef unsigned u32x2v __attribute__((ext_vector_type(2))); u32x2v w;
                    w.x = pk4_fp8(silu_f(g0[0]) * u0[0], silu_f(g0[1]) * u0[1], silu_f(g0[2]) * u0[2], silu_f(g0[3]) * u0[3]); w.y = pk4_fp8(silu_f(g1[0]) * u1[0], silu_f(g1[1]) * u1[1], silu_f(g1[2]) * u1[2], silu_f(g1[3]) * u1[3]);
                    *(u32x2v*)rowp = w; }
                else { bf16_t* rowp = O + (size_t)(row0 + ai * HALF + m * 16) * ldc + hc0;
                u32x4 w; w.x = cvt_pk_bf16(silu_f(g0[0]) * u0[0], silu_f(g0[1]) * u0[1]); w.y = cvt_pk_bf16(silu_f(g0[2]) * u0[2], silu_f(g0[3]) * u0[3]);
                w.z = cvt_pk_bf16(silu_f(g1[0]) * u1[0], silu_f(g1[1]) * u1[1]); w.w = cvt_pk_bf16(silu_f(g1[2]) * u1[2], silu_f(g1[3]) * u1[3]);
                *(u32x4*)rowp = w; } }
    }
};
struct EpiMoeDown {
    static constexpr bool PERM = true, AFTER_DRAIN = false;
    bf16_t* Y; float* slab; int pm_split, rt, ntfull; float osc;
    __device__ __forceinline__ void operator()(const f32x4 (&acc)[2][2][4][2], const Unit& u, int wr, int wc, int fr, int fq) const {
        const int col0 = (u.pn & 7) * BM + wc * 32 + 8 * fq;
        if (u.ntk != ntfull) {
            const int rl0 = (u.pm - pm_split) * BM + wr * 64 + fr; float* sp = slab + (size_t)(u.kt0 / u.ntk) * rt * 256 * 2048;
#pragma unroll
            for (int ai = 0; ai < 2; ++ai)
#pragma unroll
                for (int m = 0; m < 4; ++m) { float* rowp = sp + (size_t)(rl0 + ai * HALF + m * 16) * 2048 + col0;
#pragma unroll
                    for (int bj = 0; bj < 2; ++bj) { *(f32x4*)(rowp + bj * HALF) = acc[ai][bj][m][0] * osc; *(f32x4*)(rowp + bj * HALF + 4) = acc[ai][bj][m][1] * osc; } }
            return;
        }
        const int row0 = u.pm * BM + wr * 64 + fr;
#pragma unroll
        for (int ai = 0; ai < 2; ++ai)
#pragma unroll
            for (int m = 0; m < 4; ++m) { bf16_t* rowp = Y + (size_t)(row0 + ai * HALF + m * 16) * 2048 + col0;
#pragma unroll
                for (int bj = 0; bj < 2; ++bj) { const f32x4 v0 = acc[ai][bj][m][0] * osc, v1 = acc[ai][bj][m][1] * osc;
                    u32x4 w; w.x = cvt_pk_bf16(v0[0], v0[1]); w.y = cvt_pk_bf16(v0[2], v0[3]); w.z = cvt_pk_bf16(v1[0], v1[1]); w.w = cvt_pk_bf16(v1[2], v1[3]);
                    *(u32x4*)(rowp + bj * HALF) = w; } }
    }
};
template <class Epi, class Sched, bool ALIGN_EPI = false, bool SP2 = false, bool FP8 = false>
__device__ __forceinline__ void gemm_phase(PG8_LAS unsigned char* lds, const Gemm g, const Sched& S, const Epi& E) {
    const int tid = threadIdx.x, wid = __builtin_amdgcn_readfirstlane(tid >> 6), lane = tid & 63, wr = wid >> 2, wc = wid & 3, fr = lane & 15, fq = lane >> 4;
    const int K = g.K, nt = K / BK;
    unsigned voffA[2], voffB[2];
#pragma unroll
    for (int i = 0; i < 2; ++i) { int R, C; stage_rc(tid * 16 + i * 8192, R, C); const int Rb = Epi::PERM ? ((R & ~31) + perm32(R & 31)) : R;
        voffA[i] = (unsigned)(R * K + C) * 2u; voffB[i] = (unsigned)(Rb * K + C) * 2u; }
    const size_t kstep = (size_t)(BK * 2);
    const size_t hstep = (size_t)HALF * K * 2;
    const size_t tstep = 2 * hstep;
    const unsigned ldsw = (unsigned)wid * 1024u;
    const int aoff = lds_byte(wr * 64 + fr, fq * 8), boff = lds_byte(wc * 32 + fr, fq * 8);
#define PG8_SA(b, h) (((b) * 2 + (h)) * HTB)
#define PG8_SB(b, h) ((4 + (b) * 2 + (h)) * HTB)
#define PG8_STAGE(bufoff, gbase, voff) do { _Pragma("unroll") for (int _i = 0; _i < 2; ++_i) \
        __builtin_amdgcn_global_load_lds((const unsigned*)((const char*)(gbase) + (voff)[_i]), (PG8_LAS unsigned*)(lds + (bufoff) + ldsw + _i * 8192), 16, 0, 0); } while (0)
#define PG8_LDA(dst, b, h) do { _Pragma("unroll") for (int m = 0; m < 4; ++m) _Pragma("unroll") for (int k = 0; k < 2; ++k) dst[m][k] = *(const PG8_LAS bf16x8*)(lds + PG8_SA(b, h) + aoff + m * 2048 + k * 1024); } while (0)
#define PG8_LDB(dst, b, h) do { _Pragma("unroll") for (int n = 0; n < 2; ++n) _Pragma("unroll") for (int k = 0; k < 2; ++k) dst[n][k] = *(const PG8_LAS bf16x8*)(lds + PG8_SB(b, h) + boff + n * 2048 + k * 1024); } while (0)
    typedef int pg8_v8i __attribute__((ext_vector_type(8))); typedef int pg8_v4i __attribute__((ext_vector_type(4)));
#define PG8_CAT(x, y) __builtin_shufflevector(__builtin_bit_cast(pg8_v4i, x), __builtin_bit_cast(pg8_v4i, y), 0, 1, 2, 3, 4, 5, 6, 7)
#define PG8_MMA(ai, bj, At, Bt) do { __builtin_amdgcn_s_setprio(1); _Pragma("unroll") for (int m = 0; m < 4; ++m) _Pragma("unroll") for (int n = 0; n < 2; ++n) { \
        if constexpr (FP8) { const pg8_v8i a8_ = PG8_CAT(Bt[n][0], Bt[n][1]), b8_ = PG8_CAT(At[m][0], At[m][1]); asm volatile("v_mfma_f32_16x16x128_f8f6f4 %0, %1, %2, %0" : "+v"(acc[ai][bj][m][n]) : "v"(a8_), "v"(b8_)); } \
        else { _Pragma("unroll") for (int k = 0; k < 2; ++k) acc[ai][bj][m][n] = __builtin_amdgcn_mfma_f32_16x16x32_bf16(Bt[n][k], At[m][k], acc[ai][bj][m][n], 0, 0, 0); } } __builtin_amdgcn_s_setprio(0); } while (0)
#define PG8_WAIT_V(n) asm volatile("s_waitcnt vmcnt(" #n ")" ::: "memory")
#define PG8_WAIT_L(n) asm volatile("s_waitcnt lgkmcnt(" #n ")" ::: "memory")
#define PG8_BAR __builtin_amdgcn_s_barrier()
#define PG8_SCHED __builtin_amdgcn_sched_barrier(0)
    Unit cur, nxt; int ui = 0;
    cur.kt0 = 0; cur.ntk = nt; nxt.kt0 = 0; nxt.ntk = nt;
    if (!S.next(0, cur)) return;
    f32x4 acc[2][2][4][2];
#pragma unroll
    for (int a = 0; a < 2; ++a)
#pragma unroll
        for (int b = 0; b < 2; ++b)
#pragma unroll
            for (int m = 0; m < 4; ++m)
#pragma unroll
                for (int n = 0; n < 2; ++n) acc[a][b][m][n] = (f32x4){0.f, 0.f, 0.f, 0.f};
    bf16x8 At[4][2], B0[2][2], B1[2][2];
    const char* cA = (const char*)g.A + (size_t)cur.pm * tstep + (size_t)cur.kt0 * kstep; const char* cB = (const char*)g.Bt + (size_t)cur.pn * tstep + (size_t)cur.kt0 * kstep;
    S.a_ready(cur);
    if constexpr (SP2) {
        PG8_STAGE(PG8_SB(0, 0), cB, voffB); PG8_STAGE(PG8_SB(0, 1), cB + hstep, voffB); PG8_STAGE(PG8_SA(0, 0), cA, voffA); PG8_STAGE(PG8_SA(0, 1), cA + hstep, voffA);
        if (wr == 1) PG8_BAR;
        PG8_WAIT_V(2); PG8_BAR;
        PG8_STAGE(PG8_SB(1, 0), cB + kstep, voffB); PG8_STAGE(PG8_SA(1, 0), cA + kstep, voffA); PG8_STAGE(PG8_SB(1, 1), cB + hstep + kstep, voffB);
        PG8_WAIT_V(6); PG8_BAR;
    } else {
        PG8_STAGE(PG8_SB(0, 0), cB, voffB); PG8_STAGE(PG8_SA(0, 0), cA, voffA); PG8_STAGE(PG8_SB(0, 1), cB + hstep, voffB); PG8_STAGE(PG8_SA(0, 1), cA + hstep, voffA);
        if (wr == 1) PG8_BAR;
        PG8_WAIT_V(4); PG8_BAR;
        PG8_STAGE(PG8_SB(1, 0), cB + kstep, voffB); PG8_STAGE(PG8_SA(1, 0), cA + kstep, voffA); PG8_STAGE(PG8_SB(1, 1), cB + hstep + kstep, voffB);
        PG8_WAIT_V(6); PG8_BAR;
    }
    for (;;) {
        nxt.kt0 = 0; nxt.ntk = nt;
        const bool has_next = S.next(ui + 1, nxt);
        const char* nA = has_next ? (const char*)g.A + (size_t)nxt.pm * tstep + (size_t)nxt.kt0 * kstep : cA; const char* nB = has_next ? (const char*)g.Bt + (size_t)nxt.pn * tstep + (size_t)nxt.kt0 * kstep : cB;
        const int cnt_ = cur.ntk;
        for (int t = 0; t < cnt_; t += 2) {
            const bool last = (t == cnt_ - 2);
            const char* a1 = cA + (size_t)(t + 1) * kstep;
            const char* a2 = last ? nA : cA + (size_t)(t + 2) * kstep; const char* b2 = last ? nB : cB + (size_t)(t + 2) * kstep;
            const char* a3 = a2 + kstep; const char* b3 = b2 + kstep;
            if (last && has_next) S.a_ready(nxt);
            if constexpr (SP2) {
            PG8_LDB(B0, 0, 0); PG8_LDB(B1, 0, 1); PG8_SCHED; PG8_LDA(At, 0, 0); PG8_STAGE(PG8_SA(1, 1), a1 + hstep, voffA);
            PG8_WAIT_V(8); PG8_WAIT_L(0); PG8_BAR; PG8_MMA(0, 0, At, B0); PG8_MMA(0, 1, At, B1); PG8_BAR; PG8_SCHED;
            PG8_LDA(At, 0, 1); PG8_STAGE(PG8_SB(0, 0), b2, voffB); PG8_STAGE(PG8_SB(0, 1), b2 + hstep, voffB); PG8_STAGE(PG8_SA(0, 0), a2, voffA);
            PG8_WAIT_V(8); PG8_WAIT_L(0); PG8_BAR; PG8_MMA(1, 0, At, B0); PG8_MMA(1, 1, At, B1); PG8_BAR; PG8_SCHED;
            PG8_LDB(B0, 1, 0); PG8_LDB(B1, 1, 1); PG8_SCHED; PG8_LDA(At, 1, 0); PG8_STAGE(PG8_SA(0, 1), a2 + hstep, voffA);
            PG8_WAIT_V(8); PG8_WAIT_L(0); PG8_BAR; PG8_MMA(0, 0, At, B0); PG8_MMA(0, 1, At, B1); PG8_BAR; PG8_SCHED;
            PG8_LDA(At, 1, 1); PG8_STAGE(PG8_SB(1, 0), b3, voffB); PG8_STAGE(PG8_SB(1, 1), b3 + hstep, voffB); PG8_STAGE(PG8_SA(1, 0), a3, voffA);
            PG8_WAIT_V(8); PG8_WAIT_L(0); PG8_BAR; PG8_MMA(1, 0, At, B0); PG8_MMA(1, 1, At, B1); PG8_BAR; PG8_SCHED;
            } else {
            PG8_LDB(B0, 0, 0); PG8_SCHED; PG8_LDA(At, 0, 0); PG8_STAGE(PG8_SA(1, 1), a1 + hstep, voffA);
            PG8_WAIT_L(8); PG8_BAR; PG8_WAIT_L(0); PG8_MMA(0, 0, At, B0); PG8_BAR; PG8_SCHED;
            PG8_LDB(B1, 0, 1); PG8_STAGE(PG8_SB(0, 0), b2, voffB);
            PG8_BAR; PG8_WAIT_L(0); PG8_MMA(0, 1, At, B1); PG8_BAR;
            PG8_LDA(At, 0, 1); PG8_STAGE(PG8_SA(0, 0), a2, voffA);
            PG8_BAR; PG8_WAIT_L(0); PG8_MMA(1, 0, At, B0); PG8_BAR; PG8_SCHED;
            PG8_STAGE(PG8_SB(0, 1), b2 + hstep, voffB);
            PG8_WAIT_V(6); PG8_BAR; PG8_MMA(1, 1, At, B1); PG8_BAR;
            PG8_LDB(B0, 1, 0); PG8_SCHED; PG8_LDA(At, 1, 0); PG8_STAGE(PG8_SA(0, 1), a2 + hstep, voffA);
            PG8_WAIT_L(8); PG8_BAR; PG8_WAIT_L(0); PG8_MMA(0, 0, At, B0); PG8_BAR; PG8_SCHED;
            PG8_LDB(B1, 1, 1); PG8_STAGE(PG8_SB(1, 0), b3, voffB);
            PG8_BAR; PG8_WAIT_L(0); PG8_MMA(0, 1, At, B1); PG8_BAR;
            PG8_LDA(At, 1, 1); PG8_STAGE(PG8_SA(1, 0), a3, voffA);
            PG8_BAR; PG8_WAIT_L(0); PG8_MMA(1, 0, At, B0); PG8_BAR; PG8_SCHED;
            PG8_STAGE(PG8_SB(1, 1), b3 + hstep, voffB);
            PG8_WAIT_V(6); PG8_BAR; PG8_MMA(1, 1, At, B1); PG8_BAR;
            }
        }
        if constexpr (ALIGN_EPI) { if (wr == 0) PG8_BAR; }
        if constexpr (!Epi::AFTER_DRAIN) { E(acc, cur, wr, wc, fr, fq); S.done(cur); }
        if (!has_next) break;
#pragma unroll
        for (int a = 0; a < 2; ++a)
#pragma unroll
            for (int b = 0; b < 2; ++b)
#pragma unroll
                for (int m = 0; m < 4; ++m)
#pragma unroll
                    for (int n = 0; n < 2; ++n) acc[a][b][m][n] = (f32x4){0.f, 0.f, 0.f, 0.f};
        cur = nxt; cA = nA; cB = nB; ++ui;
        if constexpr (ALIGN_EPI) { if (wr == 1) PG8_BAR; }
    }
    PG8_WAIT_V(0);
    if constexpr (!ALIGN_EPI) { if (wr == 0) PG8_BAR; }
    PG8_BAR;
    if constexpr (Epi::AFTER_DRAIN) { E.fused(acc, cur, wr, wc, fr, fq, lds, wid, lane); S.done(cur); }
#undef PG8_SA
#undef PG8_SB
#undef PG8_STAGE
#undef PG8_LDA
#undef PG8_LDB
#undef PG8_MMA
#undef PG8_CAT
#undef PG8_WAIT_V
#undef PG8_WAIT_L
#undef PG8_BAR
#undef PG8_SCHED
}
}

namespace att {
typedef unsigned short bf16;
constexpr int   D = 128, NW = 8, QBLK = 32, KVBLK = 64;
constexpr float SCALE = 0.088388347648318440f;
constexpr float THR = 8.f;
constexpr int SDEPTH = 2;
constexpr size_t SHM_V = KVBLK * D * 2, SHM_K = KVBLK * 272, SHM_ATTN = 2 * SHM_V + 2 * SHM_K + NW * 64 * 4;
using bf16x8 = __attribute__((ext_vector_type(8))) short;
using s16x4  = __attribute__((ext_vector_type(4))) short;
using f32x16 = __attribute__((ext_vector_type(16))) float;
using f32x8  = __attribute__((ext_vector_type(8))) float;
using u32x4  = __attribute__((ext_vector_type(4))) unsigned;
#define KSWZ(row, colB) ((row) * 272 + (colB))
#define SBAR() __builtin_amdgcn_sched_barrier(0)
__device__ __forceinline__ int crow(int r, int hi) { return (r & 3) + 8 * (r >> 2) + 4 * hi; }
__device__ __forceinline__ unsigned cvtpk(float lo, float hi) {
  unsigned r; asm volatile("v_cvt_pk_bf16_f32 %0, %1, %2" : "=v"(r) : "v"(lo), "v"(hi)); return r;
}
struct StageB { using T = bf16x8;
  __device__ static __forceinline__ T ld8(const bf16* p) { return *reinterpret_cast<const bf16x8*>(p); }
  __device__ static __forceinline__ bf16x8 tobf(T x) { return x; } };
__device__ __forceinline__ void partialSM(bool fixm, f32x16& p0, f32x16& p1, float& m_reg, float& mn, float& alpha) {
  constexpr float C = SCALE * 1.4426950408889634f;
  if (fixm) {
    mn = m_reg; alpha = 1.f;
  } else {
  float pmax = p0[0]; for (int r = 1; r < 16; ++r) pmax = fmaxf(pmax, p0[r]); for (int r = 0; r < 16; ++r) pmax = fmaxf(pmax, p1[r]);
  { auto rr = __builtin_amdgcn_permlane32_swap(__float_as_uint(pmax), __float_as_uint(pmax), false, false);
    pmax = fmaxf(__uint_as_float(rr[0]), __uint_as_float(rr[1])); }
  if (__builtin_expect(__all(pmax - m_reg <= THR / SCALE), 1)) { mn = m_reg; alpha = 1.f; }
  else { mn = fmaxf(m_reg, pmax); alpha = __builtin_amdgcn_exp2f((m_reg - mn) * C); m_reg = mn; }
  }
  float mnC = -mn * C;
  for (int r = 0; r < 16; ++r) p0[r] = fmaf(p0[r], C, mnC); for (int r = 0; r < 16; ++r) p1[r] = fmaf(p1[r], C, mnC);
  for (int r = 0; r < 16; ++r) p0[r] = __builtin_amdgcn_exp2f(p0[r]);
}
__device__ __forceinline__ void finishSM(f32x16& p0, f32x16& p1, float alpha, float& l_reg, bf16x8& pa0, bf16x8& pa1, bf16x8& pa2, bf16x8& pa3) {
  for (int r = 0; r < 16; ++r) p1[r] = __builtin_amdgcn_exp2f(p1[r]);
  float ps = 0; for (int r = 0; r < 16; ++r) ps += p0[r]; for (int r = 0; r < 16; ++r) ps += p1[r];
  { auto rr = __builtin_amdgcn_permlane32_swap(__float_as_uint(ps), __float_as_uint(ps), false, false);
    ps = __uint_as_float(rr[0]) + __uint_as_float(rr[1]); }
  l_reg = l_reg * alpha + ps;
#define PK4(P, BASE, OUT) do { unsigned a0 = cvtpk(P[BASE + 0], P[BASE + 1]), a1 = cvtpk(P[BASE + 2], P[BASE + 3]);   \
    unsigned b0 = cvtpk(P[BASE + 4], P[BASE + 5]), b1 = cvtpk(P[BASE + 6], P[BASE + 7]);                              \
    auto r0 = __builtin_amdgcn_permlane32_swap(a0, b0, false, false); auto r1 = __builtin_amdgcn_permlane32_swap(a1, b1, false, false); \
    u32x4 w = {r0[0], r1[0], r0[1], r1[1]}; OUT = *reinterpret_cast<bf16x8*>(&w); } while (0)
  PK4(p0, 0, pa0); PK4(p0, 8, pa1); PK4(p1, 0, pa2); PK4(p1, 8, pa3);
#undef PK4
}
__device__ __forceinline__ void finishSM_noexp(f32x16& p0, f32x16& p1, float& l_reg, bf16x8& pa0, bf16x8& pa1, bf16x8& pa2, bf16x8& pa3) {
  float ps = 0; for (int r = 0; r < 16; ++r) ps += p0[r]; for (int r = 0; r < 16; ++r) ps += p1[r];
  { auto rr = __builtin_amdgcn_permlane32_swap(__float_as_uint(ps), __float_as_uint(ps), false, false);
    ps = __uint_as_float(rr[0]) + __uint_as_float(rr[1]); }
  l_reg += ps;
#define PK4(P, BASE, OUT) do { unsigned a0 = cvtpk(P[BASE + 0], P[BASE + 1]), a1 = cvtpk(P[BASE + 2], P[BASE + 3]);   \
    unsigned b0 = cvtpk(P[BASE + 4], P[BASE + 5]), b1 = cvtpk(P[BASE + 6], P[BASE + 7]);                              \
    auto r0 = __builtin_amdgcn_permlane32_swap(a0, b0, false, false); auto r1 = __builtin_amdgcn_permlane32_swap(a1, b1, false, false); \
    u32x4 w = {r0[0], r1[0], r0[1], r1[1]}; OUT = *reinterpret_cast<bf16x8*>(&w); } while (0)
  PK4(p0, 0, pa0); PK4(p0, 8, pa1); PK4(p1, 0, pa2); PK4(p1, 8, pa3);
#undef PK4
}
__device__ __forceinline__ void qkt(f32x16& p0, f32x16& p1, const bf16* Ks, const bf16x8* qr, int r32, int hi) {
  p0 = f32x16{}; p1 = f32x16{};
  for (int d0 = 0; d0 < 8; ++d0) { int cb = (d0 * 16 + hi * 8) * 2;
    bf16x8 b0 = *reinterpret_cast<const bf16x8*>((const char*)Ks + KSWZ(r32, cb));
    bf16x8 b1 = *reinterpret_cast<const bf16x8*>((const char*)Ks + KSWZ(32 + r32, cb));
    p0 = __builtin_amdgcn_mfma_f32_32x32x16_bf16(b0, qr[d0], p0, 0, 0, 0);
    p1 = __builtin_amdgcn_mfma_f32_32x32x16_bf16(b1, qr[d0], p1, 0, 0, 0); }
}
__device__ __forceinline__ void qkt_lean(f32x16& p0, f32x16& p1, const bf16* Ks, const bf16x8* qr, int r32, int hi) {
  p0 = f32x16{}; p1 = f32x16{};
#pragma unroll
  for (int d0 = 0; d0 < 8; ++d0) { int cb = (d0 * 16 + hi * 8) * 2;
    bf16x8 b0 = *reinterpret_cast<const bf16x8*>((const char*)Ks + KSWZ(r32, cb));
    bf16x8 b1 = *reinterpret_cast<const bf16x8*>((const char*)Ks + KSWZ(32 + r32, cb));
    p0 = __builtin_amdgcn_mfma_f32_32x32x16_bf16(b0, qr[d0], p0, 0, 0, 0);
    p1 = __builtin_amdgcn_mfma_f32_32x32x16_bf16(b1, qr[d0], p1, 0, 0, 0);
    if (d0 & 1) SBAR(); }
}
__device__ __forceinline__ int v_st(int k, int c) { const int kk = (k & ~0xC) | ((k & 4) << 1) | ((k & 8) >> 1); return ((kk >> 3) * 4 + (c >> 5)) * 512 + ((kk & 7) * 32 + (c & 31)) * 2; }
__device__ __forceinline__ int v_rd_base(int lane) { return ((lane & 3) << 3) | (((lane >> 2) & 3) << 6) | (((lane >> 4) & 1) << 5) | (((lane >> 5) & 1) << 8); }
constexpr int v_rd_off(int d0, int ks, int half) { return d0 * 512 + ks * 4096 + half * 2048; }
template <int OFF> __device__ __forceinline__ s16x4 tr_read(int vb) {
  s16x4 r; asm volatile("ds_read_b64_tr_b16 %0, %1 offset:%2" : "=&v"(r) : "v"(vb), "i"(OFF) : "memory"); return r;
}
template <int D0> __device__ __forceinline__ void pv_one(f32x16& od, int vb, bf16x8 pa0, bf16x8 pa1, bf16x8 pa2, bf16x8 pa3) {
  const s16x4 l0 = tr_read<v_rd_off(D0, 0, 0)>(vb), h0 = tr_read<v_rd_off(D0, 0, 1)>(vb), l1 = tr_read<v_rd_off(D0, 1, 0)>(vb), h1 = tr_read<v_rd_off(D0, 1, 1)>(vb);
  const s16x4 l2 = tr_read<v_rd_off(D0, 2, 0)>(vb), h2 = tr_read<v_rd_off(D0, 2, 1)>(vb), l3 = tr_read<v_rd_off(D0, 3, 0)>(vb), h3 = tr_read<v_rd_off(D0, 3, 1)>(vb);
  asm volatile("s_waitcnt lgkmcnt(0)" ::: "memory"); SBAR();
#define PK(L, H) (bf16x8){L[0], L[1], L[2], L[3], H[0], H[1], H[2], H[3]}
  od = __builtin_amdgcn_mfma_f32_32x32x16_bf16(pa0, PK(l0, h0), od, 0, 0, 0);
  od = __builtin_amdgcn_mfma_f32_32x32x16_bf16(pa1, PK(l1, h1), od, 0, 0, 0);
  od = __builtin_amdgcn_mfma_f32_32x32x16_bf16(pa2, PK(l2, h2), od, 0, 0, 0);
  od = __builtin_amdgcn_mfma_f32_32x32x16_bf16(pa3, PK(l3, h3), od, 0, 0, 0);
#undef PK
}
template <int D0> __device__ __forceinline__ void pv_two(f32x16& oa, f32x16& ob, int vb, bf16x8 pa0, bf16x8 pa1, bf16x8 pa2, bf16x8 pa3) {
  const s16x4 l0 = tr_read<v_rd_off(D0, 0, 0)>(vb), h0 = tr_read<v_rd_off(D0, 0, 1)>(vb), l1 = tr_read<v_rd_off(D0, 1, 0)>(vb), h1 = tr_read<v_rd_off(D0, 1, 1)>(vb);
  const s16x4 l2 = tr_read<v_rd_off(D0, 2, 0)>(vb), h2 = tr_read<v_rd_off(D0, 2, 1)>(vb), l3 = tr_read<v_rd_off(D0, 3, 0)>(vb), h3 = tr_read<v_rd_off(D0, 3, 1)>(vb);
  const s16x4 m0 = tr_read<v_rd_off(D0 + 1, 0, 0)>(vb), g0 = tr_read<v_rd_off(D0 + 1, 0, 1)>(vb), m1 = tr_read<v_rd_off(D0 + 1, 1, 0)>(vb), g1 = tr_read<v_rd_off(D0 + 1, 1, 1)>(vb);
  const s16x4 m2 = tr_read<v_rd_off(D0 + 1, 2, 0)>(vb), g2 = tr_read<v_rd_off(D0 + 1, 2, 1)>(vb), m3 = tr_read<v_rd_off(D0 + 1, 3, 0)>(vb), g3 = tr_read<v_rd_off(D0 + 1, 3, 1)>(vb);
  asm volatile("s_waitcnt lgkmcnt(8)" ::: "memory"); SBAR();
#define PK(L, H) (bf16x8){L[0], L[1], L[2], L[3], H[0], H[1], H[2], H[3]}
  oa = __builtin_amdgcn_mfma_f32_32x32x16_bf16(pa0, PK(l0, h0), oa, 0, 0, 0);
  oa = __builtin_amdgcn_mfma_f32_32x32x16_bf16(pa1, PK(l1, h1), oa, 0, 0, 0);
  oa = __builtin_amdgcn_mfma_f32_32x32x16_bf16(pa2, PK(l2, h2), oa, 0, 0, 0);
  oa = __builtin_amdgcn_mfma_f32_32x32x16_bf16(pa3, PK(l3, h3), oa, 0, 0, 0);
  asm volatile("s_waitcnt lgkmcnt(0)" ::: "memory"); SBAR();
  ob = __builtin_amdgcn_mfma_f32_32x32x16_bf16(pa0, PK(m0, g0), ob, 0, 0, 0);
  ob = __builtin_amdgcn_mfma_f32_32x32x16_bf16(pa1, PK(m1, g1), ob, 0, 0, 0);
  ob = __builtin_amdgcn_mfma_f32_32x32x16_bf16(pa2, PK(m2, g2), ob, 0, 0, 0);
  ob = __builtin_amdgcn_mfma_f32_32x32x16_bf16(pa3, PK(m3, g3), ob, 0, 0, 0);
#undef PK
}
__device__ __forceinline__ void pv_d0(f32x16* o, int vb, bf16x8 pa0, bf16x8 pa1, bf16x8 pa2, bf16x8 pa3) {
  pv_one<0>(o[0], vb, pa0, pa1, pa2, pa3); pv_one<1>(o[1], vb, pa0, pa1, pa2, pa3); pv_one<2>(o[2], vb, pa0, pa1, pa2, pa3); pv_one<3>(o[3], vb, pa0, pa1, pa2, pa3);
}

template <int LDQ, int LDK, int LDO, bool OBF, int SD>
__device__ __forceinline__ void attn_dense_body(const bf16* __restrict__ Qb, const bf16* __restrict__ Kh, const bf16* __restrict__ Vh,
                                                void* __restrict__ Obv, int seq, char* lds, bool fixm, float mref) {
  using St = StageB; using SQ = StageB;
#define QKT(a, b, c, d, e, f) do { if constexpr (SD == 1) qkt_lean(a, b, c, d, e, f); else qkt(a, b, c, d, e, f); } while (0)
  const int tid = threadIdx.x, wid = tid >> 6, lane = tid & 63, r32 = lane & 31, hi = lane >> 5;
  bf16* V_lds = (bf16*)lds; bf16* K_lds = (bf16*)(lds + 2 * SHM_V);
  float* ws = (float*)(lds + 2 * SHM_V + 2 * SHM_K) + wid * 64; float* li_l = ws; float* al_l = ws + 32;
  float m_reg = fixm ? mref : -1e30f, l_reg = 0; f32x16 o[4] = {}; bf16x8 qr[8];
  const bf16* Qw = Qb + (long)(wid * QBLK + r32) * LDQ + hi * 8;
#pragma unroll
  for (int d0 = 0; d0 < 8; ++d0) qr[d0] = SQ::tobf(SQ::ld8(Qw + d0 * 16));
  const int sr = tid >> 4, sc = (tid & 15) * 8, vst0 = v_st(sr, sc), vst1 = v_st(32 + sr, sc);
  const int vb0 = (int)(uintptr_t)V_lds + v_rd_base(lane);
  struct { typename St::T vs0, vs1, ks0, ks1; } sr_[SD];
  const unsigned voff0 = (unsigned)(sr * LDK + sc) * 2u, voff1 = voff0 + 32u * LDK * 2u;
#define SLOAD(i, k0) do { const char* vb_ = (const char*)Vh + (size_t)(k0) * (LDK * 2); const char* kb_ = (const char*)Kh + (size_t)(k0) * (LDK * 2); \
    sr_[i].vs0 = *(const bf16x8*)(vb_ + voff0); sr_[i].vs1 = *(const bf16x8*)(vb_ + voff1); sr_[i].ks0 = *(const bf16x8*)(kb_ + voff0); sr_[i].ks1 = *(const bf16x8*)(kb_ + voff1); } while (0)
#define SWRITE(b, i) do { *(bf16x8*)((char*)V_lds + (b) * SHM_V + vst0) = St::tobf(sr_[i].vs0);          \
    *(bf16x8*)((char*)V_lds + (b) * SHM_V + vst1) = St::tobf(sr_[i].vs1); int kc = sc * 2;               \
    *(bf16x8*)((char*)K_lds + (b) * SHM_K + KSWZ(sr, kc)) = St::tobf(sr_[i].ks0);                       \
    *(bf16x8*)((char*)K_lds + (b) * SHM_K + KSWZ(32 + sr, kc)) = St::tobf(sr_[i].ks1); } while (0)
#define SWAIT() do { if constexpr (SD == 2) asm volatile("s_waitcnt vmcnt(4)" ::: "memory"); else asm volatile("s_waitcnt vmcnt(0)" ::: "memory"); } while (0)
#define RESC(a) do { if (!fixm && __any((a) < 1.f)) { if (hi == 0) al_l[r32] = (a); asm volatile("s_waitcnt lgkmcnt(0)" ::: "memory"); \
    for (int d = 0; d < 4; ++d) for (int r = 0; r < 16; ++r) o[d][r] *= al_l[crow(r, hi)]; } } while (0)
  f32x16 pA0, pA1, pB0, pB1; float mnA, mnB, alA, alB; bf16x8 pa0, pa1, pa2, pa3; const int NT = seq / KVBLK;
  constexpr int SE = 0, SO = SD - 1;
  SLOAD(SE, 0); asm volatile("s_waitcnt vmcnt(0)" ::: "memory"); SWRITE(0, SE); __syncthreads();
  QKT(pA0, pA1, K_lds, qr, r32, hi); partialSM(fixm, pA0, pA1, m_reg, mnA, alA);
  SLOAD(SO, KVBLK); if constexpr (SD == 2) { if (2 < NT) SLOAD(SE, 2 * KVBLK); }
  SWAIT(); SWRITE(1, SO); __syncthreads();
  for (int j = 1; j + 1 < NT; j += 2) {
    SBAR(); QKT(pB0, pB1, (bf16*)((char*)K_lds + SHM_K), qr, r32, hi);
    finishSM(pA0, pA1, alA, l_reg, pa0, pa1, pa2, pa3); SBAR();
    SLOAD(SO, (j + SD) * KVBLK); SBAR();
    pv_d0(o, vb0, pa0, pa1, pa2, pa3); partialSM(fixm, pB0, pB1, m_reg, mnB, alB);
    __syncthreads(); SWAIT(); SWRITE(0, SE);
    RESC(alB); __syncthreads();
    SBAR(); QKT(pA0, pA1, K_lds, qr, r32, hi);
    finishSM(pB0, pB1, alB, l_reg, pa0, pa1, pa2, pa3); SBAR();
    if (SD == 1 || j + 3 < NT) SLOAD(SE, (j + 1 + SD) * KVBLK); SBAR();
    pv_d0(o, vb0 + (int)SHM_V, pa0, pa1, pa2, pa3); partialSM(fixm, pA0, pA1, m_reg, mnA, alA);
    __syncthreads(); SWAIT(); SWRITE(1, SO);
    RESC(alA); __syncthreads();
  }
  SBAR(); QKT(pB0, pB1, (bf16*)((char*)K_lds + SHM_K), qr, r32, hi);
  finishSM(pA0, pA1, alA, l_reg, pa0, pa1, pa2, pa3); SBAR();
  pv_d0(o, vb0, pa0, pa1, pa2, pa3); partialSM(fixm, pB0, pB1, m_reg, mnB, alB);
  __syncthreads(); RESC(alB);
  finishSM(pB0, pB1, alB, l_reg, pa0, pa1, pa2, pa3); SBAR();
  pv_d0(o, vb0 + (int)SHM_V, pa0, pa1, pa2, pa3);
  { int r32e = r32; asm volatile("" : "+v"(r32e)); if (hi == 0) li_l[r32e] = l_reg; } asm volatile("s_waitcnt lgkmcnt(0)" ::: "memory");
  int r32e = r32, hie = hi; asm volatile("" : "+v"(r32e), "+v"(hie));
  float rli[16];
#pragma unroll
  for (int r = 0; r < 16; ++r) rli[r] = __builtin_amdgcn_rcpf(li_l[crow(r, hie)]);
  if constexpr (OBF) {
    bf16* Ow = (bf16*)Obv + (long)(wid * QBLK + 4 * hie) * LDO + r32e;
#pragma unroll
    for (int r = 0; r < 16; ++r) { const int orow = (r & 3) + 8 * (r >> 2);
      for (int d0 = 0; d0 < 4; ++d0) { const float v = o[d0][r] * rli[r]; unsigned u = __float_as_uint(v); u = (u + 0x7fffu + ((u >> 16) & 1u)) >> 16; Ow[(long)orow * LDO + d0 * 32] = (bf16)u; } }
  } else {
    float* rowp = (float*)Obv + (long)(wid * QBLK + 4 * hie) * LDO + r32e;
#pragma unroll
    for (int g = 0; g < 4; ++g) { float* pg = rowp + (long)(8 * g) * LDO; asm volatile("" : "+v"(pg));
#pragma unroll
      for (int i = 0; i < 4; ++i)
#pragma unroll
        for (int d0 = 0; d0 < 4; ++d0) pg[(long)i * LDO + d0 * 32] = o[d0][4 * g + i] * rli[4 * g + i]; }
  }
#undef SLOAD
#undef QKT
#undef SWRITE
#undef SWAIT
#undef RESC
}

constexpr size_t PB_V = 32768, PB_K = KVBLK * 272, PB_P = 4096;
constexpr size_t PB_OFF_K = 2 * PB_V, PB_OFF_P = PB_OFF_K + 2 * PB_K, PB_OFF_L = PB_OFF_P + 8 * PB_P, SHM_PAIR = PB_OFF_L + 2 * 8 * 32 * 4;
template <int LDQ, int LDK, int LDV, int LDO>
__device__ __forceinline__ void attn_pair_body(const bf16* __restrict__ Qb, const bf16* __restrict__ Kh, const bf16* __restrict__ Vh, float* __restrict__ Ob, int seq, char* lds, float mref) {
  const int tid = threadIdx.x, wid = tid >> 6, lane = tid & 63, r32 = lane & 31, hi = lane >> 5, rb = wid & 3, ch = wid >> 2;
  char* V_lds = lds; char* K_lds = lds + PB_OFF_K; char* P_lds = lds + PB_OFF_P + rb * PB_P + lane * 16; float* L_lds = (float*)(lds + PB_OFF_L);
  float m_reg = mref, l_reg = 0.f, mn, al; f32x16 o[4] = {}; bf16x8 qr[8];
  const bf16* Qw = Qb + (long)(rb * QBLK + r32) * LDQ + hi * 8;
#pragma unroll
  for (int d0 = 0; d0 < 8; ++d0) qr[d0] = *reinterpret_cast<const bf16x8*>(Qw + d0 * 16);
  const int sr = tid >> 4, sc = (tid & 15) * 8, vst0 = v_st(sr, sc), vst1 = v_st(32 + sr, sc);
  const int vb0 = (int)(uintptr_t)V_lds + ch * 16384 + v_rd_base(lane);
  bf16x8 sv0, sv1, sv2, sv3, sk0, sk1;
  const unsigned koff0 = (unsigned)(sr * LDK + sc) * 2u, koff1 = koff0 + 32u * LDK * 2u, voff0 = (unsigned)(sr * LDV + sc) * 2u, voff1 = voff0 + 32u * LDV * 2u;
#define PLOADV(kt) do { const char* vb_ = (const char*)Vh + (size_t)(kt) * (64 * LDV * 2); sv0 = *(const bf16x8*)(vb_ + voff0); sv1 = *(const bf16x8*)(vb_ + voff1); sv2 = *(const bf16x8*)(vb_ + voff0 + 256); sv3 = *(const bf16x8*)(vb_ + voff1 + 256); } while (0)
#define PLOADK(kt) do { const char* kb_ = (const char*)Kh + (size_t)(kt) * (64 * LDK * 2); sk0 = *(const bf16x8*)(kb_ + koff0); sk1 = *(const bf16x8*)(kb_ + koff1); } while (0)
#define PWRITEV(b) do { char* d_ = V_lds + (b) * PB_V; *(bf16x8*)(d_ + vst0) = sv0; *(bf16x8*)(d_ + vst1) = sv1; *(bf16x8*)(d_ + 16384 + vst0) = sv2; *(bf16x8*)(d_ + 16384 + vst1) = sv3; } while (0)
#define PWRITEK(b) do { char* d_ = K_lds + (b) * PB_K; *(bf16x8*)(d_ + KSWZ(sr, sc * 2)) = sk0; *(bf16x8*)(d_ + KSWZ(32 + sr, sc * 2)) = sk1; } while (0)
#define PSTORE(par) do { char* d_ = P_lds + (par) * (4 * PB_P); *(bf16x8*)(d_) = pa0; *(bf16x8*)(d_ + 1024) = pa1; *(bf16x8*)(d_ + 2048) = pa2; *(bf16x8*)(d_ + 3072) = pa3; } while (0)
#define PFETCH(par) do { const char* d_ = P_lds + (par) * (4 * PB_P); pa0 = *(const bf16x8*)(d_); pa1 = *(const bf16x8*)(d_ + 1024); pa2 = *(const bf16x8*)(d_ + 2048); pa3 = *(const bf16x8*)(d_ + 3072); } while (0)
  const int NT = seq / KVBLK; f32x16 p0, p1; bf16x8 pa0, pa1, pa2, pa3;
  PLOADK(0); PLOADV(0); asm volatile("s_waitcnt vmcnt(0)" ::: "memory"); PWRITEK(0); PWRITEV(0);
  PLOADK(1); asm volatile("s_waitcnt vmcnt(0)" ::: "memory"); PWRITEK(1); __syncthreads();
  PLOADK(2); PLOADV(1);
  if (ch == 0) { qkt(p0, p1, (bf16*)K_lds, qr, r32, hi); partialSM(true, p0, p1, m_reg, mn, al); finishSM(p0, p1, 1.f, l_reg, pa0, pa1, pa2, pa3); PSTORE(0); }
  for (int t = 0; t < NT; ++t) {
    __syncthreads();
    asm volatile("s_waitcnt vmcnt(0)" ::: "memory");
    if (t + 2 < NT) PWRITEK(t & 1);
    if (t + 1 < NT) PWRITEV((t + 1) & 1);
    PLOADK(t + 3); PLOADV(t + 2);
    SBAR();
    const int vb = vb0 + (t & 1) * (int)PB_V;
    if ((t ^ ch) & 1) {
      const bool more = t + 1 < NT;
      PFETCH(t & 1);
      if (more) { qkt(p0, p1, (bf16*)(K_lds + ((t + 1) & 1) * PB_K), qr, r32, hi); partialSM(true, p0, p1, m_reg, mn, al); }
      pv_d0(o, vb, pa0, pa1, pa2, pa3);
      if (more) { finishSM(p0, p1, 1.f, l_reg, pa0, pa1, pa2, pa3); PSTORE((t + 1) & 1); }
    } else {
      pv_d0(o, vb, pa0, pa1, pa2, pa3);
    }
  }
  __syncthreads();
  int r32e = r32, hie = hi, wide = wid; asm volatile("" : "+v"(r32e), "+v"(hie), "+v"(wide));
  if (hie == 0) L_lds[wide * 32 + r32e] = l_reg;
  __syncthreads();
  const int rbe = wide & 3, che = wide >> 2;
  float rli[16];
#pragma unroll
  for (int r = 0; r < 16; ++r) { const int rr = crow(r, hie); rli[r] = __builtin_amdgcn_rcpf(L_lds[rbe * 32 + rr] + L_lds[(rbe + 4) * 32 + rr]); }
  float* rowp = Ob + (long)(rbe * QBLK + 4 * hie) * LDO + che * 128 + r32e;
#pragma unroll
  for (int g = 0; g < 4; ++g) { float* pg = rowp + (long)(8 * g) * LDO; asm volatile("" : "+v"(pg));
#pragma unroll
    for (int i = 0; i < 4; ++i)
#pragma unroll
      for (int d0 = 0; d0 < 4; ++d0) pg[(long)i * LDO + d0 * 32] = o[d0][4 * g + i] * rli[4 * g + i]; }
#undef PLOADV
#undef PLOADK
#undef PWRITEV
#undef PWRITEK
#undef PSTORE
#undef PFETCH
}

template <int LDQ, int LDK, int LDV, int LDO>
__device__ __forceinline__ void attn_pair2_body(const bf16* __restrict__ Qb, const bf16* __restrict__ Kh, const bf16* __restrict__ Vh, float* __restrict__ Ob, int seq, char* lds, float mref) {
  const int tid = threadIdx.x, wid = tid >> 6, lane = tid & 63, r32 = lane & 31, hi = lane >> 5, rb = wid & 3, ch = wid >> 2;
  char* V_lds = lds; char* K_lds = lds + PB_OFF_K; float* L_lds = (float*)(lds + PB_OFF_L);
  char* P_own = lds + PB_OFF_P + rb * PB_P + ch * 2048 + lane * 16; char* P_oth = lds + PB_OFF_P + rb * PB_P + (1 - ch) * 2048 + lane * 16;
  constexpr float C = SCALE * 1.4426950408889634f; const float mnC = -mref * C;
  float l_reg = 0.f; f32x16 o[4] = {}; bf16x8 qr[8];
  const bf16* Qw = Qb + (long)(rb * QBLK + r32) * LDQ + hi * 8;
#pragma unroll
  for (int d0 = 0; d0 < 8; ++d0) qr[d0] = *reinterpret_cast<const bf16x8*>(Qw + d0 * 16);
  const int sr = tid >> 4, sc = (tid & 15) * 8, vst0 = v_st(sr, sc), vst1 = v_st(32 + sr, sc);
  const int vb0 = (int)(uintptr_t)V_lds + ch * 16384 + v_rd_base(lane);
  const int kq = KSWZ(32 * ch + r32, hi * 16);
  bf16x8 sv0, sv1, sv2, sv3, sk0, sk1;
  const unsigned koff0 = (unsigned)(sr * LDK + sc) * 2u, koff1 = koff0 + 32u * LDK * 2u, voff0 = (unsigned)(sr * LDV + sc) * 2u, voff1 = voff0 + 32u * LDV * 2u;
#define PLOADV(kt) do { const char* vb_ = (const char*)Vh + (size_t)(kt) * (64 * LDV * 2); sv0 = *(const bf16x8*)(vb_ + voff0); sv1 = *(const bf16x8*)(vb_ + voff1); sv2 = *(const bf16x8*)(vb_ + voff0 + 256); sv3 = *(const bf16x8*)(vb_ + voff1 + 256); } while (0)
#define PLOADK(kt) do { const char* kb_ = (const char*)Kh + (size_t)(kt) * (64 * LDK * 2); sk0 = *(const bf16x8*)(kb_ + koff0); sk1 = *(const bf16x8*)(kb_ + koff1); } while (0)
#define PWRITEV(b) do { char* d_ = V_lds + (b) * PB_V; *(bf16x8*)(d_ + vst0) = sv0; *(bf16x8*)(d_ + vst1) = sv1; *(bf16x8*)(d_ + 16384 + vst0) = sv2; *(bf16x8*)(d_ + 16384 + vst1) = sv3; } while (0)
#define PWRITEK(b) do { char* d_ = K_lds + (b) * PB_K; *(bf16x8*)(d_ + KSWZ(sr, sc * 2)) = sk0; *(bf16x8*)(d_ + KSWZ(32 + sr, sc * 2)) = sk1; } while (0)
#define SCORE_MMA(kb) do { p = f32x16{}; const char* kp_ = K_lds + (kb) * PB_K + kq; \
    _Pragma("unroll") for (int d0 = 0; d0 < 8; ++d0) { const bf16x8 b_ = *reinterpret_cast<const bf16x8*>(kp_ + d0 * 32); p = __builtin_amdgcn_mfma_f32_32x32x16_bf16(b_, qr[d0], p, 0, 0, 0); } } while (0)
#define SCORE_SM(par) do { \
    _Pragma("unroll") for (int r = 0; r < 16; ++r) p[r] = __builtin_amdgcn_exp2f(fmaf(p[r], C, mnC)); \
    float ps_ = 0.f; _Pragma("unroll") for (int r = 0; r < 16; ++r) ps_ += p[r]; \
    { auto rr_ = __builtin_amdgcn_permlane32_swap(__float_as_uint(ps_), __float_as_uint(ps_), false, false); ps_ = __uint_as_float(rr_[0]) + __uint_as_float(rr_[1]); } l_reg += ps_; \
    { unsigned a0 = cvtpk(p[0], p[1]), a1 = cvtpk(p[2], p[3]), b0 = cvtpk(p[4], p[5]), b1 = cvtpk(p[6], p[7]); auto r0 = __builtin_amdgcn_permlane32_swap(a0, b0, false, false); auto r1 = __builtin_amdgcn_permlane32_swap(a1, b1, false, false); \
      u32x4 w = {r0[0], r1[0], r0[1], r1[1]}; pa0 = *reinterpret_cast<bf16x8*>(&w); } \
    { unsigned a0 = cvtpk(p[8], p[9]), a1 = cvtpk(p[10], p[11]), b0 = cvtpk(p[12], p[13]), b1 = cvtpk(p[14], p[15]); auto r0 = __builtin_amdgcn_permlane32_swap(a0, b0, false, false); auto r1 = __builtin_amdgcn_permlane32_swap(a1, b1, false, false); \
      u32x4 w = {r0[0], r1[0], r0[1], r1[1]}; pa1 = *reinterpret_cast<bf16x8*>(&w); } \
    { char* d_ = P_own + (par) * (4 * PB_P); *(bf16x8*)(d_) = pa0; *(bf16x8*)(d_ + 1024) = pa1; } } while (0)
  const int NT = seq / KVBLK; bf16x8 pa0, pa1; f32x16 p;
  PLOADK(0); PLOADV(0); asm volatile("s_waitcnt vmcnt(0)" ::: "memory"); PWRITEK(0); PWRITEV(0);
  PLOADK(1); asm volatile("s_waitcnt vmcnt(0)" ::: "memory"); PWRITEK(1); __syncthreads();
  PLOADK(2); PLOADV(1);
  SCORE_MMA(0); SCORE_SM(0);
  for (int t = 0; t < NT; ++t) {
    __syncthreads();
    bf16x8 pb0, pb1; { const char* d_ = P_oth + (t & 1) * (4 * PB_P); pb0 = *(const bf16x8*)(d_); pb1 = *(const bf16x8*)(d_ + 1024); }
    const bool more = t + 1 < NT;
    if (more) SCORE_MMA((t + 1) & 1);
    const bf16x8 A0 = ch ? pb0 : pa0, A1 = ch ? pb1 : pa1, A2 = ch ? pa0 : pb0, A3 = ch ? pa1 : pb1;
    const int vb = vb0 + (t & 1) * (int)PB_V;
    SBAR(); pv_two<0>(o[0], o[1], vb, A0, A1, A2, A3); SBAR();
    asm volatile("s_waitcnt vmcnt(0)" ::: "memory");
    if (t + 2 < NT) PWRITEK(t & 1);
    if (t + 1 < NT) PWRITEV((t + 1) & 1);
    PLOADK(t + 3); PLOADV(t + 2);
    SBAR(); pv_two<2>(o[2], o[3], vb, A0, A1, A2, A3); SBAR();
    if (more) SCORE_SM((t + 1) & 1);
  }
  __syncthreads();
  int r32e = r32, hie = hi, wide = wid; asm volatile("" : "+v"(r32e), "+v"(hie), "+v"(wide));
  if (hie == 0) L_lds[wide * 32 + r32e] = l_reg;
  __syncthreads();
  const int rbe = wide & 3, che = wide >> 2;
  float rli[16];
#pragma unroll
  for (int r = 0; r < 16; ++r) { const int rr = crow(r, hie); rli[r] = __builtin_amdgcn_rcpf(L_lds[rbe * 32 + rr] + L_lds[(rbe + 4) * 32 + rr]); }
  float* rowp = Ob + (long)(rbe * QBLK + 4 * hie) * LDO + che * 128 + r32e;
#pragma unroll
  for (int g = 0; g < 4; ++g) { float* pg = rowp + (long)(8 * g) * LDO; asm volatile("" : "+v"(pg));
#pragma unroll
    for (int i = 0; i < 4; ++i)
#pragma unroll
      for (int d0 = 0; d0 < 4; ++d0) pg[(long)i * LDO + d0 * 32] = o[d0][4 * g + i] * rli[4 * g + i]; }
#undef PLOADV
#undef PLOADK
#undef PWRITEV
#undef PWRITEK
#undef SCORE_MMA
#undef SCORE_SM
}

template <int LDQ, int LDK, int LDV, int LDO, int DMX>
__device__ __forceinline__ void attn_diff2_body(const bf16* __restrict__ Qb0, const bf16* __restrict__ Kh0, const bf16* __restrict__ Vh, float* __restrict__ Ob, bf16* __restrict__ Mx, int seq, char* lds, float mref, float lam, float osc, const float* __restrict__ sg) {
  const int tid = threadIdx.x, wid = tid >> 6, lane = tid & 63, r32 = lane & 31, hi = lane >> 5, rb = wid & 3, ch = wid >> 2;
  char* V_lds = lds; char* K_lds = lds + PB_OFF_K; float* L_lds = (float*)(lds + PB_OFF_L);
  char* P_own = lds + PB_OFF_P + rb * PB_P + ch * 2048 + lane * 16; char* P_oth = lds + PB_OFF_P + rb * PB_P + (1 - ch) * 2048 + lane * 16;
  constexpr float C = SCALE * 1.4426950408889634f; const float mnC = -mref * C;
  float* S_lds = L_lds + 8 * 32;
  const int sr = tid >> 4, sc = (tid & 15) * 8, vst0 = v_st(sr, sc), vst1 = v_st(32 + sr, sc);
  const int vb0 = (int)(uintptr_t)V_lds + ch * 16384 + v_rd_base(lane);
  const int kq = KSWZ(32 * ch + r32, hi * 16);
  bf16x8 sv0, sv1, sv2, sv3, sk0, sk1;
  const unsigned koff0 = (unsigned)(sr * LDK + sc) * 2u, koff1 = koff0 + 32u * LDK * 2u, voff0 = (unsigned)(sr * LDV + sc) * 2u, voff1 = voff0 + 32u * LDV * 2u;
#define PLOADV(kt) do { const char* vb_ = (const char*)Vh + (size_t)(kt) * (64 * LDV * 2); sv0 = *(const bf16x8*)(vb_ + voff0); sv1 = *(const bf16x8*)(vb_ + voff1); sv2 = *(const bf16x8*)(vb_ + voff0 + 256); sv3 = *(const bf16x8*)(vb_ + voff1 + 256); } while (0)
#define PLOADK(kt) do { const char* kb_ = (const char*)Kh + (size_t)(kt) * (64 * LDK * 2); sk0 = *(const bf16x8*)(kb_ + koff0); sk1 = *(const bf16x8*)(kb_ + koff1); } while (0)
#define PWRITEV(b) do { char* d_ = V_lds + (b) * PB_V; *(bf16x8*)(d_ + vst0) = sv0; *(bf16x8*)(d_ + vst1) = sv1; *(bf16x8*)(d_ + 16384 + vst0) = sv2; *(bf16x8*)(d_ + 16384 + vst1) = sv3; } while (0)
#define PWRITEK(b) do { char* d_ = K_lds + (b) * PB_K; *(bf16x8*)(d_ + KSWZ(sr, sc * 2)) = sk0; *(bf16x8*)(d_ + KSWZ(32 + sr, sc * 2)) = sk1; } while (0)
#define SCORE_MMA(kb) do { p = f32x16{}; const char* kp_ = K_lds + (kb) * PB_K + kq; \
    _Pragma("unroll") for (int d0 = 0; d0 < 8; ++d0) { const bf16x8 b_ = *reinterpret_cast<const bf16x8*>(kp_ + d0 * 32); p = __builtin_amdgcn_mfma_f32_32x32x16_bf16(b_, qr[d0], p, 0, 0, 0); } } while (0)
#define SCORE_SM(par) do { \
    _Pragma("unroll") for (int r = 0; r < 16; ++r) p[r] = __builtin_amdgcn_exp2f(fmaf(p[r], C, mnC)); \
    float ps_ = 0.f; _Pragma("unroll") for (int r = 0; r < 16; ++r) ps_ += p[r]; \
    { auto rr_ = __builtin_amdgcn_permlane32_swap(__float_as_uint(ps_), __float_as_uint(ps_), false, false); ps_ = __uint_as_float(rr_[0]) + __uint_as_float(rr_[1]); } l_reg += ps_; \
    { unsigned a0 = cvtpk(p[0], p[1]), a1 = cvtpk(p[2], p[3]), b0 = cvtpk(p[4], p[5]), b1 = cvtpk(p[6], p[7]); auto r0 = __builtin_amdgcn_permlane32_swap(a0, b0, false, false); auto r1 = __builtin_amdgcn_permlane32_swap(a1, b1, false, false); \
      u32x4 w = {r0[0], r1[0], r0[1], r1[1]}; pa0 = *reinterpret_cast<bf16x8*>(&w); } \
    { unsigned a0 = cvtpk(p[8], p[9]), a1 = cvtpk(p[10], p[11]), b0 = cvtpk(p[12], p[13]), b1 = cvtpk(p[14], p[15]); auto r0 = __builtin_amdgcn_permlane32_swap(a0, b0, false, false); auto r1 = __builtin_amdgcn_permlane32_swap(a1, b1, false, false); \
      u32x4 w = {r0[0], r1[0], r0[1], r1[1]}; pa1 = *reinterpret_cast<bf16x8*>(&w); } \
    { char* d_ = P_own + (par) * (4 * PB_P); *(bf16x8*)(d_) = pa0; *(bf16x8*)(d_ + 1024) = pa1; } } while (0)
  const int NT = seq / KVBLK;
#pragma unroll 1
  for (int pass = 0; pass < 2; ++pass) {
  const bf16* Kh = Kh0 + pass * 128; bf16x8 pa0, pa1; f32x16 p;
  float l_reg = 0.f; f32x16 o[4] = {}; bf16x8 qr[8];
  { int r32q = r32, hiq = hi, widq = wid; asm volatile("" : "+v"(r32q), "+v"(hiq), "+v"(widq));
    const bf16* Qw = Qb0 + pass * 128 + (long)((widq & 3) * QBLK + r32q) * LDQ + hiq * 8;
#pragma unroll
    for (int d0 = 0; d0 < 8; ++d0) qr[d0] = *reinterpret_cast<const bf16x8*>(Qw + d0 * 16); }
  PLOADK(0); PLOADV(0); asm volatile("s_waitcnt vmcnt(0)" ::: "memory"); PWRITEK(0); PWRITEV(0);
  PLOADK(1); asm volatile("s_waitcnt vmcnt(0)" ::: "memory"); PWRITEK(1); __syncthreads();
  PLOADK(2); PLOADV(1);
  SCORE_MMA(0); SCORE_SM(0);
  if (wid >= 4) __builtin_amdgcn_s_setprio(1);
  for (int t = 0; t < NT; ++t) {
    __syncthreads();
    bf16x8 pb0, pb1; { const char* d_ = P_oth + (t & 1) * (4 * PB_P); pb0 = *(const bf16x8*)(d_); pb1 = *(const bf16x8*)(d_ + 1024); }
    const bool more = t + 1 < NT;
    if (more) SCORE_MMA((t + 1) & 1);
    const bf16x8 A0 = ch ? pb0 : pa0, A1 = ch ? pb1 : pa1, A2 = ch ? pa0 : pb0, A3 = ch ? pa1 : pb1;
    const int vb = vb0 + (t & 1) * (int)PB_V;
    SBAR(); pv_two<0>(o[0], o[1], vb, A0, A1, A2, A3); SBAR();
    asm volatile("s_waitcnt vmcnt(0)" ::: "memory");
    if (t + 2 < NT) PWRITEK(t & 1);
    if (t + 1 < NT) PWRITEV((t + 1) & 1);
    PLOADK(t + 3); PLOADV(t + 2);
    SBAR(); pv_two<2>(o[2], o[3], vb, A0, A1, A2, A3); SBAR();
    if (more) SCORE_SM((t + 1) & 1);
  }
  __builtin_amdgcn_s_setprio(0);
  __syncthreads();
  int r32e = r32, hie = hi, wide = wid; asm volatile("" : "+v"(r32e), "+v"(hie), "+v"(wide));
  if (hie == 0) L_lds[wide * 32 + r32e] = l_reg;
  __syncthreads();
  const int rbe = wide & 3, che = wide >> 2;
  float rli[16];
#pragma unroll
  for (int r = 0; r < 16; ++r) { const int rr = crow(r, hie); rli[r] = __builtin_amdgcn_rcpf(L_lds[rbe * 32 + rr] + L_lds[(rbe + 4) * 32 + rr]); }
  float* rowp = Ob + (long)(rbe * QBLK + 4 * hie) * LDO + che * 128 + r32e;
  if (pass == 0) {
#pragma unroll
    for (int g = 0; g < 4; ++g) { float* pg = rowp + (long)(8 * g) * LDO; asm volatile("" : "+v"(pg));
#pragma unroll
      for (int i = 0; i < 4; ++i)
#pragma unroll
        for (int d0 = 0; d0 < 4; ++d0) pg[(long)i * LDO + d0 * 32] = o[d0][4 * g + i] * rli[4 * g + i]; }
  } else {
    float ssq[16];
#pragma unroll
    for (int g = 0; g < 4; ++g) { const float* pg = rowp + (long)(8 * g) * LDO; asm volatile("" : "+v"(pg));
#pragma unroll
      for (int i = 0; i < 4; ++i) { float q_ = 0.f;
#pragma unroll
        for (int d0 = 0; d0 < 4; ++d0) { const float v = pg[(long)i * LDO + d0 * 32] - lam * (o[d0][4 * g + i] * rli[4 * g + i]); o[d0][4 * g + i] = v; q_ += v * v; }
        ssq[4 * g + i] = q_; } }
#pragma unroll
    for (int r = 0; r < 16; ++r) { float q_ = ssq[r];
#pragma unroll
      for (int m_ = 1; m_ < 32; m_ <<= 1) q_ += __shfl_xor(q_, m_);
      ssq[r] = q_; }
    if (r32e == 0) {
#pragma unroll
      for (int r = 0; r < 16; ++r) S_lds[wide * 32 + crow(r, hie)] = ssq[r]; }
    __syncthreads();
    bf16* mrow = Mx + (long)(rbe * QBLK + 4 * hie) * DMX + che * 128 + r32e;
    float sgv[4];
#pragma unroll
    for (int d0 = 0; d0 < 4; ++d0) sgv[d0] = sg[che * 128 + d0 * 32 + r32e];
#pragma unroll
    for (int g = 0; g < 4; ++g) { bf16* pm_ = mrow + (long)(8 * g) * DMX; asm volatile("" : "+v"(pm_));
#pragma unroll
      for (int i = 0; i < 4; ++i) { const int rr = 8 * g + i + 4 * hie; const float sc_ = osc / sqrtf((S_lds[rbe * 32 + rr] + S_lds[(rbe + 4) * 32 + rr]) * (1.0f / 256.0f) + 1e-6f);
#pragma unroll
        for (int d0 = 0; d0 < 4; ++d0) { const float v = o[d0][4 * g + i] * sc_ * sgv[d0]; unsigned u = __float_as_uint(v); u = (u + 0x7fffu + ((u >> 16) & 1u)) >> 16; pm_[(long)i * DMX + d0 * 32] = (bf16)u; } } }
  }
  __syncthreads();
  }
#undef PLOADV
#undef PLOADK
#undef PWRITEV
#undef PWRITEK
#undef SCORE_MMA
#undef SCORE_SM
}


constexpr size_t GB_V = 16384, GB_K = KVBLK * 272, GB_OFF_K = 2 * GB_V, SHM_GQA2 = GB_OFF_K + 2 * GB_K;
template <int LDQ, int LDK, int LDO>
__device__ __forceinline__ void attn_gqa2_body(const bf16* __restrict__ Qb, const bf16* __restrict__ Kh, const bf16* __restrict__ Vh, bf16* __restrict__ Ob, int seq, char* lds, float mref) {
  const int tid = threadIdx.x, wid = tid >> 6, lane = tid & 63, r32 = lane & 31, hi = lane >> 5;
  char* V_lds = lds; char* K_lds = lds + GB_OFF_K;
  constexpr float C = SCALE * 1.4426950408889634f; const float mnC = -mref * C;
  float l_reg = 0.f; f32x16 o[4] = {}; bf16x8 qr[8];
  { int r32q = r32, hiq = hi, widq = wid; asm volatile("" : "+v"(r32q), "+v"(hiq), "+v"(widq));
    const bf16* Qw = Qb + (widq >> 2) * 128 + (long)((widq & 3) * QBLK + r32q) * LDQ + hiq * 8;
#pragma unroll
    for (int d0 = 0; d0 < 8; ++d0) qr[d0] = *reinterpret_cast<const bf16x8*>(Qw + d0 * 16); }
  const int sr = tid >> 4, sc = (tid & 15) * 8, vst0 = v_st(sr, sc), vst1 = v_st(32 + sr, sc);
  const int vb0 = (int)(uintptr_t)V_lds + v_rd_base(lane);
  bf16x8 sv0, sv1, sk0, sk1;
  const unsigned koff0 = (unsigned)(sr * LDK + sc) * 2u, koff1 = koff0 + 32u * LDK * 2u;
#define GLOADV(kt) do { const char* vb_ = (const char*)Vh + (size_t)(kt) * (64 * LDK * 2); sv0 = *(const bf16x8*)(vb_ + koff0); sv1 = *(const bf16x8*)(vb_ + koff1); } while (0)
#define GLOADK(kt) do { const char* kb_ = (const char*)Kh + (size_t)(kt) * (64 * LDK * 2); sk0 = *(const bf16x8*)(kb_ + koff0); sk1 = *(const bf16x8*)(kb_ + koff1); } while (0)
#define GWRITEV(b) do { char* d_ = V_lds + (b) * GB_V; *(bf16x8*)(d_ + vst0) = sv0; *(bf16x8*)(d_ + vst1) = sv1; } while (0)
#define GWRITEK(b) do { char* d_ = K_lds + (b) * GB_K; *(bf16x8*)(d_ + KSWZ(sr, sc * 2)) = sk0; *(bf16x8*)(d_ + KSWZ(32 + sr, sc * 2)) = sk1; } while (0)
#define GSCORE_SM() do { \
    _Pragma("unroll") for (int r = 0; r < 16; ++r) { p0[r] = __builtin_amdgcn_exp2f(fmaf(p0[r], C, mnC)); p1[r] = __builtin_amdgcn_exp2f(fmaf(p1[r], C, mnC)); } \
    finishSM(p0, p1, 1.f, l_reg, pa0, pa1, pa2, pa3); } while (0)
  const int NT = seq / KVBLK; bf16x8 pa0, pa1, pa2, pa3; f32x16 p0, p1;
  GLOADK(0); GLOADV(0); asm volatile("s_waitcnt vmcnt(0)" ::: "memory"); GWRITEK(0); GWRITEV(0);
  GLOADK(1); asm volatile("s_waitcnt vmcnt(0)" ::: "memory"); GWRITEK(1); __syncthreads();
  GLOADK(2); GLOADV(1);
  qkt(p0, p1, (bf16*)K_lds, qr, r32, hi);
  { _Pragma("unroll") for (int r = 0; r < 16; ++r) { p0[r] = __builtin_amdgcn_exp2f(fmaf(p0[r], C, mnC)); p1[r] = __builtin_amdgcn_exp2f(fmaf(p1[r], C, mnC)); } }
  if (wid >= 4) __builtin_amdgcn_s_setprio(1);
  for (int t = 0; t < NT; ++t) {
    finishSM_noexp(p0, p1, l_reg, pa0, pa1, pa2, pa3);
    __syncthreads();
    const bool more = t + 1 < NT;
    if (more) qkt(p0, p1, (bf16*)(K_lds + ((t + 1) & 1) * GB_K), qr, r32, hi);
    const int vb = vb0 + (t & 1) * (int)GB_V;
    SBAR(); pv_two<0>(o[0], o[1], vb, pa0, pa1, pa2, pa3); SBAR();
    asm volatile("s_waitcnt vmcnt(0)" ::: "memory");
    if (t + 2 < NT) GWRITEK(t & 1);
    if (t + 1 < NT) GWRITEV((t + 1) & 1);
    GLOADK(t + 3); GLOADV(t + 2);
    SBAR(); pv_two<2>(o[2], o[3], vb, pa0, pa1, pa2, pa3); SBAR();
    if (more) { _Pragma("unroll") for (int r = 0; r < 16; ++r) { p0[r] = __builtin_amdgcn_exp2f(fmaf(p0[r], C, mnC)); p1[r] = __builtin_amdgcn_exp2f(fmaf(p1[r], C, mnC)); } }
  }
  __builtin_amdgcn_s_setprio(0);
  int r32e = r32, hie = hi, wide = wid; asm volatile("" : "+v"(r32e), "+v"(hie), "+v"(wide));
  float* li_l = (float*)(lds + SHM_GQA2) + wide * 32;
  __syncthreads();
  if (hie == 0) li_l[r32e] = l_reg;
  asm volatile("s_waitcnt lgkmcnt(0)" ::: "memory");
  float rli[16];
#pragma unroll
  for (int r = 0; r < 16; ++r) rli[r] = __builtin_amdgcn_rcpf(li_l[crow(r, hie)]);
  bf16* Ow = Ob + (wide >> 2) * 128 + (long)((wide & 3) * QBLK + 4 * hie) * LDO + r32e;
#pragma unroll
  for (int r = 0; r < 16; ++r) { const int orow = (r & 3) + 8 * (r >> 2);
#pragma unroll
    for (int d0 = 0; d0 < 4; ++d0) { const float v = o[d0][r] * rli[r]; unsigned u = __float_as_uint(v); u = (u + 0x7fffu + ((u >> 16) & 1u)) >> 16; Ow[(long)orow * LDO + d0 * 32] = (bf16)u; } }
#undef GLOADV
#undef GLOADK
#undef GWRITEV
#undef GWRITEK
#undef GSCORE_SM
}

constexpr int VP16 = 2080;
using f32x4a = __attribute__((ext_vector_type(4))) float; using u32x2a = __attribute__((ext_vector_type(2))) unsigned;
constexpr size_t G16_V = 8 * VP16, G16_OFF_K = 2 * G16_V, SHM_G16 = G16_OFF_K + 2 * GB_K;
#define MFMA16(a, b, c) __builtin_amdgcn_mfma_f32_16x16x32_bf16(a, b, c, 0, 0, 0)
#define PK16(L, H) (bf16x8){L[0], L[1], L[2], L[3], H[0], H[1], H[2], H[3]}
template <int D0> __device__ __forceinline__ void pv16(f32x4a (&o)[8][2], int vb, const bf16x8 (&pb)[2][2]) {
#define TR(dt, j, h) tr_read<(dt) * VP16 + (j) * 1024 + (h) * 512>(vb)
  const s16x4 a0 = TR(D0, 0, 0), a1 = TR(D0, 0, 1), a2 = TR(D0, 1, 0), a3 = TR(D0, 1, 1), b0 = TR(D0 + 1, 0, 0), b1 = TR(D0 + 1, 0, 1), b2 = TR(D0 + 1, 1, 0), b3 = TR(D0 + 1, 1, 1);
  const s16x4 c0 = TR(D0 + 2, 0, 0), c1 = TR(D0 + 2, 0, 1), c2 = TR(D0 + 2, 1, 0), c3 = TR(D0 + 2, 1, 1);
  asm volatile("s_waitcnt lgkmcnt(4)" ::: "memory"); SBAR();
  o[D0][0] = MFMA16(PK16(a0, a1), pb[0][0], o[D0][0]); o[D0][1] = MFMA16(PK16(a0, a1), pb[0][1], o[D0][1]);
  o[D0 + 1][0] = MFMA16(PK16(b0, b1), pb[0][0], o[D0 + 1][0]); o[D0 + 1][1] = MFMA16(PK16(b0, b1), pb[0][1], o[D0 + 1][1]);
  o[D0][0] = MFMA16(PK16(a2, a3), pb[1][0], o[D0][0]); o[D0][1] = MFMA16(PK16(a2, a3), pb[1][1], o[D0][1]);
  o[D0 + 1][0] = MFMA16(PK16(b2, b3), pb[1][0], o[D0 + 1][0]); o[D0 + 1][1] = MFMA16(PK16(b2, b3), pb[1][1], o[D0 + 1][1]);
  SBAR();
  const s16x4 d0 = TR(D0 + 3, 0, 0), d1 = TR(D0 + 3, 0, 1), d2 = TR(D0 + 3, 1, 0), d3 = TR(D0 + 3, 1, 1);
  asm volatile("s_waitcnt lgkmcnt(4)" ::: "memory"); SBAR();
  o[D0 + 2][0] = MFMA16(PK16(c0, c1), pb[0][0], o[D0 + 2][0]); o[D0 + 2][1] = MFMA16(PK16(c0, c1), pb[0][1], o[D0 + 2][1]);
  o[D0 + 2][0] = MFMA16(PK16(c2, c3), pb[1][0], o[D0 + 2][0]); o[D0 + 2][1] = MFMA16(PK16(c2, c3), pb[1][1], o[D0 + 2][1]);
  asm volatile("s_waitcnt lgkmcnt(0)" ::: "memory"); SBAR();
  o[D0 + 3][0] = MFMA16(PK16(d0, d1), pb[0][0], o[D0 + 3][0]); o[D0 + 3][1] = MFMA16(PK16(d0, d1), pb[0][1], o[D0 + 3][1]);
  o[D0 + 3][0] = MFMA16(PK16(d2, d3), pb[1][0], o[D0 + 3][0]); o[D0 + 3][1] = MFMA16(PK16(d2, d3), pb[1][1], o[D0 + 3][1]);
#undef TR
}
template <int LDQ, int LDK, int LDO>
__device__ __forceinline__ void attn_gqa16_body(const bf16* __restrict__ Qb, const bf16* __restrict__ Kh, const bf16* __restrict__ Vh, bf16* __restrict__ Ob, int seq, char* lds, float mref) {
  const int tid = threadIdx.x, wid = tid >> 6, lane = tid & 63, l16 = lane & 15, g = lane >> 4;
  char* V_lds = lds; char* K_lds = lds + G16_OFF_K;
  constexpr float C = SCALE * 1.4426950408889634f; const float mnC = -mref * C;
  float ls0 = 0.f, ls1 = 0.f; f32x4a o[8][2] = {}; bf16x8 qr[2][4];
  { int l16q = l16, gq = g, widq = wid; asm volatile("" : "+v"(l16q), "+v"(gq), "+v"(widq));
    const bf16* Qw = Qb + (widq >> 2) * 128 + (long)((widq & 3) * QBLK + l16q) * LDQ + gq * 8;
#pragma unroll
    for (int qt = 0; qt < 2; ++qt)
#pragma unroll
      for (int ds = 0; ds < 4; ++ds) qr[qt][ds] = *reinterpret_cast<const bf16x8*>(Qw + (long)qt * 16 * LDQ + ds * 32); }
  const int sr = tid >> 4, sc = (tid & 15) * 8;
  const int vst0 = (sc >> 4) * VP16 + sr * 32 + ((sc >> 3) & 1) * 16, vst1 = vst0 + 1024;
  const int vb0 = (int)(uintptr_t)V_lds + (4 * g + (l16 >> 2)) * 32 + (l16 & 3) * 8;
  const int kb0 = l16 * 272 + g * 16;
  bf16x8 sv0, sv1, sk0, sk1;
  const unsigned koff0 = (unsigned)(sr * LDK + sc) * 2u, koff1 = koff0 + 32u * LDK * 2u;
#define HLOADV(kt) do { const char* vb_ = (const char*)Vh + (size_t)(kt) * (64 * LDK * 2); sv0 = *(const bf16x8*)(vb_ + koff0); sv1 = *(const bf16x8*)(vb_ + koff1); } while (0)
#define HLOADK(kt) do { const char* kb_ = (const char*)Kh + (size_t)(kt) * (64 * LDK * 2); sk0 = *(const bf16x8*)(kb_ + koff0); sk1 = *(const bf16x8*)(kb_ + koff1); } while (0)
#define HWRITEV(b) do { char* d_ = V_lds + (b) * G16_V; *(bf16x8*)(d_ + vst0) = sv0; *(bf16x8*)(d_ + vst1) = sv1; } while (0)
#define HWRITEK(b) do { char* d_ = K_lds + (b) * GB_K; *(bf16x8*)(d_ + KSWZ(sr, sc * 2)) = sk0; *(bf16x8*)(d_ + KSWZ(32 + sr, sc * 2)) = sk1; } while (0)
  f32x4a s[4][2]; bf16x8 pb[2][2];
#define HQK(kbuf) do { const char* kp_ = K_lds + (kbuf) * GB_K + kb0; \
    _Pragma("unroll") for (int kt = 0; kt < 4; ++kt) { s[kt][0] = f32x4a{0.f, 0.f, 0.f, 0.f}; s[kt][1] = f32x4a{0.f, 0.f, 0.f, 0.f}; } \
    _Pragma("unroll") for (int ds = 0; ds < 4; ++ds) { \
      _Pragma("unroll") for (int kt = 0; kt < 4; ++kt) { const bf16x8 a_ = *reinterpret_cast<const bf16x8*>(kp_ + kt * (16 * 272) + ds * 64); \
        s[kt][0] = MFMA16(a_, qr[0][ds], s[kt][0]); s[kt][1] = MFMA16(a_, qr[1][ds], s[kt][1]); } } } while (0)
#define HEXP() do { _Pragma("unroll") for (int kt = 0; kt < 4; ++kt) { _Pragma("unroll") for (int qt = 0; qt < 2; ++qt) { _Pragma("unroll") for (int i = 0; i < 4; ++i) s[kt][qt][i] = __builtin_amdgcn_exp2f(fmaf(s[kt][qt][i], C, mnC)); } } } while (0)
#define HPACK() do { \
    _Pragma("unroll") for (int kt = 0; kt < 4; ++kt) { ls0 += (s[kt][0][0] + s[kt][0][1]) + (s[kt][0][2] + s[kt][0][3]); ls1 += (s[kt][1][0] + s[kt][1][1]) + (s[kt][1][2] + s[kt][1][3]); } \
    _Pragma("unroll") for (int j = 0; j < 2; ++j) { _Pragma("unroll") for (int qt = 0; qt < 2; ++qt) { \
      u32x4 w_ = {cvtpk(s[2 * j][qt][0], s[2 * j][qt][1]), cvtpk(s[2 * j][qt][2], s[2 * j][qt][3]), cvtpk(s[2 * j + 1][qt][0], s[2 * j + 1][qt][1]), cvtpk(s[2 * j + 1][qt][2], s[2 * j + 1][qt][3])}; \
      pb[j][qt] = *reinterpret_cast<bf16x8*>(&w_); } } } while (0)
  const int NT = seq / KVBLK;
  HLOADK(0); HLOADV(0); asm volatile("s_waitcnt vmcnt(0)" ::: "memory"); HWRITEK(0); HWRITEV(0);
  HLOADK(1); asm volatile("s_waitcnt vmcnt(0)" ::: "memory"); HWRITEK(1); __syncthreads();
  HLOADK(2); HLOADV(1);
  HQK(0); HEXP();
  if (wid >= 4) __builtin_amdgcn_s_setprio(1);
  for (int t = 0; t < NT; ++t) {
    HPACK();
    __syncthreads();
    const bool more = t + 1 < NT;
    if (more) HQK((t + 1) & 1);
    const int vb = vb0 + (t & 1) * (int)G16_V;
    SBAR(); pv16<0>(o, vb, pb); SBAR();
    asm volatile("s_waitcnt vmcnt(0)" ::: "memory");
    if (t + 2 < NT) HWRITEK(t & 1);
    if (t + 1 < NT) HWRITEV((t + 1) & 1);
    HLOADK(t + 3); HLOADV(t + 2);
    SBAR(); pv16<4>(o, vb, pb); SBAR();
    if (more) HEXP();
  }
  __builtin_amdgcn_s_setprio(0);
  ls0 += __shfl_xor(ls0, 16); ls0 += __shfl_xor(ls0, 32); ls1 += __shfl_xor(ls1, 16); ls1 += __shfl_xor(ls1, 32);
  const float rl[2] = {__builtin_amdgcn_rcpf(ls0), __builtin_amdgcn_rcpf(ls1)};
  int l16e = l16, ge = g, wide = wid; asm volatile("" : "+v"(l16e), "+v"(ge), "+v"(wide));
  bf16* Ow = Ob + (wide >> 2) * 128 + (long)((wide & 3) * QBLK + l16e) * LDO + 4 * ge;
#pragma unroll
  for (int qt = 0; qt < 2; ++qt)
#pragma unroll
    for (int dt = 0; dt < 8; ++dt) { unsigned u_[4];
#pragma unroll
      for (int i = 0; i < 4; ++i) { const float v = o[dt][qt][i] * rl[qt]; unsigned u = __float_as_uint(v); u_[i] = (u + 0x7fffu + ((u >> 16) & 1u)) >> 16; }
      u32x2a w_ = {u_[0] | (u_[1] << 16), u_[2] | (u_[3] << 16)};
      *reinterpret_cast<u32x2a*>(Ow + (long)qt * 16 * LDO + dt * 16) = w_; }
#undef HLOADV
#undef HLOADK
#undef HWRITEV
#undef HWRITEK
#undef HQK
#undef HEXP
#undef HPACK
}

constexpr size_t D16_V = 16 * VP16, D16_OFF_K = 2 * D16_V, D16_OFF_P = D16_OFF_K + 2 * PB_K, D16_OFF_L = D16_OFF_P + 8 * PB_P, SHM_D16 = D16_OFF_L + 2 * 8 * 32 * 4;
template <int D0> __device__ __forceinline__ void pv16d(f32x4a (&o)[8][2], int vbo, int vbp, const bf16x8 (&po)[2], const bf16x8 (&pp)[2]) {
#define TRO(dt, h) tr_read<(dt) * VP16 + (h) * 512>(vbo)
#define TRP(dt, h) tr_read<(dt) * VP16 + (h) * 512>(vbp)
  const s16x4 a0 = TRO(D0, 0), a1 = TRO(D0, 1), a2 = TRP(D0, 0), a3 = TRP(D0, 1), b0 = TRO(D0 + 1, 0), b1 = TRO(D0 + 1, 1), b2 = TRP(D0 + 1, 0), b3 = TRP(D0 + 1, 1);
  const s16x4 c0 = TRO(D0 + 2, 0), c1 = TRO(D0 + 2, 1), c2 = TRP(D0 + 2, 0), c3 = TRP(D0 + 2, 1);
  asm volatile("s_waitcnt lgkmcnt(4)" ::: "memory"); SBAR();
  o[D0][0] = MFMA16(PK16(a0, a1), po[0], o[D0][0]); o[D0][1] = MFMA16(PK16(a0, a1), po[1], o[D0][1]);
  o[D0 + 1][0] = MFMA16(PK16(b0, b1), po[0], o[D0 + 1][0]); o[D0 + 1][1] = MFMA16(PK16(b0, b1), po[1], o[D0 + 1][1]);
  o[D0][0] = MFMA16(PK16(a2, a3), pp[0], o[D0][0]); o[D0][1] = MFMA16(PK16(a2, a3), pp[1], o[D0][1]);
  o[D0 + 1][0] = MFMA16(PK16(b2, b3), pp[0], o[D0 + 1][0]); o[D0 + 1][1] = MFMA16(PK16(b2, b3), pp[1], o[D0 + 1][1]);
  SBAR();
  const s16x4 d0 = TRO(D0 + 3, 0), d1 = TRO(D0 + 3, 1), d2 = TRP(D0 + 3, 0), d3 = TRP(D0 + 3, 1);
  asm volatile("s_waitcnt lgkmcnt(4)" ::: "memory"); SBAR();
  o[D0 + 2][0] = MFMA16(PK16(c0, c1), po[0], o[D0 + 2][0]); o[D0 + 2][1] = MFMA16(PK16(c0, c1), po[1], o[D0 + 2][1]);
  o[D0 + 2][0] = MFMA16(PK16(c2, c3), pp[0], o[D0 + 2][0]); o[D0 + 2][1] = MFMA16(PK16(c2, c3), pp[1], o[D0 + 2][1]);
  asm volatile("s_waitcnt lgkmcnt(0)" ::: "memory"); SBAR();
  o[D0 + 3][0] = MFMA16(PK16(d0, d1), po[0], o[D0 + 3][0]); o[D0 + 3][1] = MFMA16(PK16(d0, d1), po[1], o[D0 + 3][1]);
  o[D0 + 3][0] = MFMA16(PK16(d2, d3), pp[0], o[D0 + 3][0]); o[D0 + 3][1] = MFMA16(PK16(d2, d3), pp[1], o[D0 + 3][1]);
#undef TRO
#undef TRP
}
template <int LDQ, int LDK, int LDV, int LDO, int DMX>
__device__ __forceinline__ void attn_diff16_body(const bf16* __restrict__ Qb0, const bf16* __restrict__ Kh0, const bf16* __restrict__ Vh, float* __restrict__ Ob, bf16* __restrict__ Mx, int seq, char* lds, float mref, float lam, float osc, const float* __restrict__ sg) {
  const int tid = threadIdx.x, wid = tid >> 6, lane = tid & 63, l16 = lane & 15, g = lane >> 4, rb = wid & 3, ch = wid >> 2;
  char* V_lds = lds; char* K_lds = lds + D16_OFF_K; float* L_lds = (float*)(lds + D16_OFF_L); float* S_lds = L_lds + 8 * 32;
  char* P_own = lds + D16_OFF_P + rb * PB_P + ch * 2048 + lane * 16; char* P_oth = lds + D16_OFF_P + rb * PB_P + (1 - ch) * 2048 + lane * 16;
  constexpr float C = SCALE * 1.4426950408889634f; const float mnC = -mref * C;
  const int sr = tid >> 4, sc = (tid & 15) * 8;
  const int vst0 = (sc >> 4) * VP16 + sr * 32 + ((sc >> 3) & 1) * 16, vst1 = vst0 + 1024;
  const int vlane = (int)(uintptr_t)V_lds + ch * (8 * VP16) + (4 * g + (l16 >> 2)) * 32 + (l16 & 3) * 8;
  const int kb0 = (32 * ch + l16) * 272 + g * 16;
  bf16x8 sv0, sv1, sv2, sv3, sk0, sk1;
  const unsigned koff0 = (unsigned)(sr * LDK + sc) * 2u, koff1 = koff0 + 32u * LDK * 2u, voff0 = (unsigned)(sr * LDV + sc) * 2u, voff1 = voff0 + 32u * LDV * 2u;
#define ELOADV(kt) do { const char* vb_ = (const char*)Vh + (size_t)(kt) * (64 * LDV * 2); sv0 = *(const bf16x8*)(vb_ + voff0); sv1 = *(const bf16x8*)(vb_ + voff1); sv2 = *(const bf16x8*)(vb_ + voff0 + 256); sv3 = *(const bf16x8*)(vb_ + voff1 + 256); } while (0)
#define ELOADK(kt) do { const char* kb_ = (const char*)Kh + (size_t)(kt) * (64 * LDK * 2); sk0 = *(const bf16x8*)(kb_ + koff0); sk1 = *(const bf16x8*)(kb_ + koff1); } while (0)
#define EWRITEV(b) do { char* d_ = V_lds + (b) * D16_V; *(bf16x8*)(d_ + vst0) = sv0; *(bf16x8*)(d_ + vst1) = sv1; *(bf16x8*)(d_ + 8 * VP16 + vst0) = sv2; *(bf16x8*)(d_ + 8 * VP16 + vst1) = sv3; } while (0)
#define EWRITEK(b) do { char* d_ = K_lds + (b) * PB_K; *(bf16x8*)(d_ + KSWZ(sr, sc * 2)) = sk0; *(bf16x8*)(d_ + KSWZ(32 + sr, sc * 2)) = sk1; } while (0)
#define EQK(kbuf) do { const char* kp_ = K_lds + (kbuf) * PB_K + kb0; \
    s[0][0] = f32x4a{0.f, 0.f, 0.f, 0.f}; s[0][1] = s[0][0]; s[1][0] = s[0][0]; s[1][1] = s[0][0]; \
    _Pragma("unroll") for (int ds = 0; ds < 4; ++ds) { \
      _Pragma("unroll") for (int kt = 0; kt < 2; ++kt) { const bf16x8 a_ = *reinterpret_cast<const bf16x8*>(kp_ + kt * (16 * 272) + ds * 64); \
        s[kt][0] = MFMA16(a_, qr[0][ds], s[kt][0]); s[kt][1] = MFMA16(a_, qr[1][ds], s[kt][1]); } } } while (0)
#define ESM(par) do { \
    _Pragma("unroll") for (int kt = 0; kt < 2; ++kt) { _Pragma("unroll") for (int qt = 0; qt < 2; ++qt) { _Pragma("unroll") for (int i = 0; i < 4; ++i) s[kt][qt][i] = __builtin_amdgcn_exp2f(fmaf(s[kt][qt][i], C, mnC)); } } \
    ls0 += ((s[0][0][0] + s[0][0][1]) + (s[0][0][2] + s[0][0][3])) + ((s[1][0][0] + s[1][0][1]) + (s[1][0][2] + s[1][0][3])); \
    ls1 += ((s[0][1][0] + s[0][1][1]) + (s[0][1][2] + s[0][1][3])) + ((s[1][1][0] + s[1][1][1]) + (s[1][1][2] + s[1][1][3])); \
    _Pragma("unroll") for (int qt = 0; qt < 2; ++qt) { \
      u32x4 w_ = {cvtpk(s[0][qt][0], s[0][qt][1]), cvtpk(s[0][qt][2], s[0][qt][3]), cvtpk(s[1][qt][0], s[1][qt][1]), cvtpk(s[1][qt][2], s[1][qt][3])}; po[qt] = *reinterpret_cast<bf16x8*>(&w_); } \
    { char* d_ = P_own + (par) * (4 * PB_P); *(bf16x8*)(d_) = po[0]; *(bf16x8*)(d_ + 1024) = po[1]; } } while (0)
  const int NT = seq / KVBLK;
#pragma unroll 1
  for (int pass = 0; pass < 2; ++pass) {
  const bf16* Kh = Kh0 + pass * 128;
  float ls0 = 0.f, ls1 = 0.f; f32x4a o[8][2] = {}; bf16x8 qr[2][4]; f32x4a s[2][2]; bf16x8 po[2];
  { int l16q = l16, gq = g, widq = wid; asm volatile("" : "+v"(l16q), "+v"(gq), "+v"(widq));
    const bf16* Qw = Qb0 + pass * 128 + (long)((widq & 3) * QBLK + l16q) * LDQ + gq * 8;
#pragma unroll
    for (int qt = 0; qt < 2; ++qt)
#pragma unroll
      for (int ds = 0; ds < 4; ++ds) qr[qt][ds] = *reinterpret_cast<const bf16x8*>(Qw + (long)qt * 16 * LDQ + ds * 32); }
  ELOADK(0); ELOADV(0); asm volatile("s_waitcnt vmcnt(0)" ::: "memory"); EWRITEK(0); EWRITEV(0);
  ELOADK(1); asm volatile("s_waitcnt vmcnt(0)" ::: "memory"); EWRITEK(1); __syncthreads();
  ELOADK(2); ELOADV(1);
  EQK(0); ESM(0);
  if (wid >= 4) __builtin_amdgcn_s_setprio(1);
  for (int t = 0; t < NT; ++t) {
    __syncthreads();
    bf16x8 pp[2]; { const char* d_ = P_oth + (t & 1) * (4 * PB_P); pp[0] = *(const bf16x8*)(d_); pp[1] = *(const bf16x8*)(d_ + 1024); }
    const bf16x8 pc[2] = {po[0], po[1]};
    const bool more = t + 1 < NT;
    if (more) EQK((t + 1) & 1);
    const int vb = vlane + (t & 1) * (int)D16_V, vbo = vb + ch * 1024, vbp = vb + (1 - ch) * 1024;
    SBAR(); pv16d<0>(o, vbo, vbp, pc, pp); SBAR();
    asm volatile("s_waitcnt vmcnt(0)" ::: "memory");
    if (t + 2 < NT) EWRITEK(t & 1);
    if (t + 1 < NT) EWRITEV((t + 1) & 1);
    ELOADK(t + 3); ELOADV(t + 2);
    SBAR(); pv16d<4>(o, vbo, vbp, pc, pp); SBAR();
    if (more) ESM((t + 1) & 1);
  }
  __builtin_amdgcn_s_setprio(0);
  ls0 += __shfl_xor(ls0, 16); ls0 += __shfl_xor(ls0, 32); ls1 += __shfl_xor(ls1, 16); ls1 += __shfl_xor(ls1, 32);
  __syncthreads();
  int l16e = l16, ge = g, wide = wid; asm volatile("" : "+v"(l16e), "+v"(ge), "+v"(wide));
  const int rbe = wide & 3, che = wide >> 2;
  if (ge == 0) { L_lds[wide * 32 + l16e] = ls0; L_lds[wide * 32 + 16 + l16e] = ls1; }
  __syncthreads();
  float rl[2];
#pragma unroll
  for (int qt = 0; qt < 2; ++qt) rl[qt] = __builtin_amdgcn_rcpf(L_lds[rbe * 32 + 16 * qt + l16e] + L_lds[(rbe + 4) * 32 + 16 * qt + l16e]);
  float* rowp = Ob + (long)(rbe * QBLK + l16e) * LDO + che * 128 + 4 * ge;
  if (pass == 0) {
#pragma unroll
    for (int qt = 0; qt < 2; ++qt) { float* pq = rowp + (long)qt * 16 * LDO; asm volatile("" : "+v"(pq));
#pragma unroll
      for (int dt = 0; dt < 8; ++dt) *reinterpret_cast<f32x4a*>(pq + dt * 16) = o[dt][qt] * rl[qt]; }
  } else {
    float ssq[2];
#pragma unroll
    for (int qt = 0; qt < 2; ++qt) { const float* pq = rowp + (long)qt * 16 * LDO; asm volatile("" : "+v"(pq)); float q_ = 0.f;
#pragma unroll
      for (int dt = 0; dt < 8; ++dt) { const f32x4a v = *reinterpret_cast<const f32x4a*>(pq + dt * 16) - lam * (o[dt][qt] * rl[qt]); o[dt][qt] = v; q_ += (v[0] * v[0] + v[1] * v[1]) + (v[2] * v[2] + v[3] * v[3]); }
      q_ += __shfl_xor(q_, 16); q_ += __shfl_xor(q_, 32); ssq[qt] = q_; }
    if (ge == 0) { S_lds[wide * 32 + l16e] = ssq[0]; S_lds[wide * 32 + 16 + l16e] = ssq[1]; }
    __syncthreads();
    bf16* mrow = Mx + (long)(rbe * QBLK + l16e) * DMX + che * 128 + 4 * ge;
#pragma unroll
    for (int qt = 0; qt < 2; ++qt) { bf16* pm_ = mrow + (long)qt * 16 * DMX; asm volatile("" : "+v"(pm_));
      const int rr = 16 * qt + l16e; const float sc_ = osc / sqrtf((S_lds[rbe * 32 + rr] + S_lds[(rbe + 4) * 32 + rr]) * (1.0f / 256.0f) + 1e-6f);
#pragma unroll
      for (int dt = 0; dt < 8; ++dt) { const f32x4a gv = *reinterpret_cast<const f32x4a*>(sg + che * 128 + dt * 16 + 4 * ge); unsigned u_[4];
#pragma unroll
        for (int i = 0; i < 4; ++i) { const float v = o[dt][qt][i] * sc_ * gv[i]; unsigned u = __float_as_uint(v); u_[i] = (u + 0x7fffu + ((u >> 16) & 1u)) >> 16; }
        u32x2a w_ = {u_[0] | (u_[1] << 16), u_[2] | (u_[3] << 16)};
        *reinterpret_cast<u32x2a*>(pm_ + dt * 16) = w_; } }
  }
  __syncthreads();
  }
#undef ELOADV
#undef ELOADK
#undef EWRITEV
#undef EWRITEK
#undef EQK
#undef ESM
}

#undef KSWZ
#undef SBAR
}

constexpr int DM = 2048, SEQ = 16384, CTXL = 256, NTOK = SEQ + CTXL;
constexpr int EV_IN = 4624, EV_LD = 4608, EV_NP = 4864;
constexpr int FFD = 5632, FFE = 7168, OD_LD = 6144;
constexpr int NCH = 260;
constexpr int MAXROWS = 34816;
constexpr float EPS = 1e-6f;
constexpr float EXGU_SCALE = 32.0f;
constexpr float EXDN_SCALE = 64.0f;
constexpr int NWAVES = 8;
constexpr size_t MiB = 1u << 20;
constexpr size_t WS_CTL = 0, CTL_ZERO_BYTES = 1 * MiB;
constexpr int CW_BAR = 4096, CW_CNT = 8192;
constexpr size_t WS_MOD = 512 * 1024;
constexpr size_t al256(size_t x) { return (x + 255) / 256 * 256; }
constexpr size_t WS_TAB = 1 * MiB;
constexpr size_t WS_G = WS_TAB + 64 * 1024;
constexpr size_t WS_GP = WS_G + al256((size_t)NTOK * 16 * 4);
constexpr size_t WS_GS = WS_GP + al256((size_t)8 * NCH * 192 * 4);
constexpr size_t WS_NS = WS_GS + al256((size_t)8 * NCH * 8 * 4);
constexpr size_t WS_TOK = WS_NS + al256((size_t)8 * NCH * 128 * 4);
constexpr size_t WS_ROW = WS_TOK + al256((size_t)SEQ * 6 * 4);
constexpr size_t WS_XC = al256(WS_ROW + (size_t)MAXROWS * 8);
constexpr size_t WS_W_EVIN = al256(WS_XC + (size_t)CTXL * DM * 4);
constexpr size_t WS_W_EVOUT = WS_W_EVIN + (size_t)EV_NP * DM * 2;
constexpr size_t WS_W_EVGU = WS_W_EVOUT + (size_t)DM * DM * 2;
constexpr size_t WS_W_EVDN = WS_W_EVGU + (size_t)2 * FFD * DM * 2;
constexpr size_t WS_W_ODIN = WS_W_EVDN + (size_t)DM * FFD * 2;
constexpr size_t WS_W_ODOUT = WS_W_ODIN + (size_t)OD_LD * DM * 2;
constexpr size_t WS_W_EXGU = WS_W_ODOUT + (size_t)DM * DM * 2;
constexpr size_t WS_W_EXDN = WS_W_EXGU + (size_t)8 * 2 * FFE * DM * 2;
constexpr size_t WS_H = WS_W_EXDN + (size_t)8 * DM * FFE * 2;
constexpr size_t WS_PROJ = WS_H + (size_t)NTOK * DM * 2;
constexpr size_t WS_MIX = WS_PROJ + (size_t)NTOK * OD_LD * 2;
constexpr size_t WS_BIG = WS_MIX + (size_t)NTOK * DM * 2;
constexpr size_t WS_END = WS_BIG + (size_t)MAXROWS * FFE * 2;
static_assert((size_t)8 * NCH * 32768 * 2 <= (size_t)MAXROWS * FFE * 2 && (size_t)NTOK * FFD * 2 <= (size_t)MAXROWS * FFE * 2 && (size_t)SEQ * 4096 * 4 <= (size_t)MAXROWS * FFE * 2, "overlay");
static_assert((size_t)MAXROWS * DM * 2 <= (size_t)NTOK * OD_LD * 2, "permuted input fits PROJ");
constexpr int RING_BYTES = 139264, MISC_OFF = RING_BYTES + 320, LDS_BYTES = 147456;
static_assert(att::SHM_D16 <= (size_t)RING_BYTES && att::SHM_G16 <= (size_t)RING_BYTES && att::SHM_PAIR <= (size_t)RING_BYTES && att::SHM_ATTN <= (size_t)RING_BYTES && att::SHM_GQA2 + 1024 <= (size_t)RING_BYTES, "attention LDS");

#define LAS __attribute__((address_space(3)))
typedef unsigned short bf16;
typedef short bf16x8 __attribute__((ext_vector_type(8)));
typedef float f32x4 __attribute__((ext_vector_type(4)));
typedef float f32x16 __attribute__((ext_vector_type(16)));
typedef unsigned u32x4 __attribute__((ext_vector_type(4)));
typedef unsigned u32x2 __attribute__((ext_vector_type(2)));
#define LDS_WAIT() asm volatile("s_waitcnt lgkmcnt(0)" ::: "memory")
__device__ __forceinline__ float bf2f(unsigned b) { return __uint_as_float(b << 16); }
__device__ __forceinline__ unsigned f2bf(float f) { unsigned u = __float_as_uint(f); return (u + 0x7fffu + ((u >> 16) & 1u)) >> 16; }
__device__ __forceinline__ unsigned pk2(float lo, float hi) { return pg8::cvt_pk_bf16(lo, hi); }
__device__ __forceinline__ float wave_sum(float v) {
#pragma unroll
    for (int o = 1; o < 64; o <<= 1) v += __shfl_xor(v, o);
    return v;
}
__device__ __forceinline__ float wave_max(float v) {
#pragma unroll
    for (int o = 1; o < 64; o <<= 1) v = fmaxf(v, __shfl_xor(v, o));
    return v;
}

#define XB_TMO      128
#define XB_XCNT(j)  (256  + 64 * (j))
#define XB_XSUB(j)  (1280 + 64 * (j))
#define XB_XGEN(j)  (2304 + 64 * (j))
#define XB_TOP      3328
#define XB_TOPGEN   3392
#define XCD_BAR_WORDS 3456
#define XB_SPIN_CAP (1u << 18)

__device__ __forceinline__ unsigned xb_ld(unsigned* p)              { return __hip_atomic_load(p, __ATOMIC_RELAXED, __HIP_MEMORY_SCOPE_AGENT); }
__device__ __forceinline__ unsigned xb_add(unsigned* p, unsigned v) { return __hip_atomic_fetch_add(p, v, __ATOMIC_RELAXED, __HIP_MEMORY_SCOPE_AGENT); }
__device__ __forceinline__ unsigned xb_xcc_id() { return (unsigned)__builtin_amdgcn_s_getreg((3 << 11) | 20) & 0xFu; }
#define XB_SPIN(cond, bar) do { unsigned _sp = 0; while (cond) { __builtin_amdgcn_s_sleep(1); \
    if ((++_sp & 255u) == 0u) { if (xb_ld(&(bar)[XB_TMO])) break; if (_sp > XB_SPIN_CAP) { atomicAdd(&(bar)[XB_TMO], 1u); break; } } } } while (0)

struct XcdBarrier {
    unsigned* bar; unsigned x;
    volatile LAS unsigned* st;
};

__device__ __forceinline__ XcdBarrier xcd_barrier_post(unsigned* bar, volatile LAS unsigned* st) {
    XcdBarrier b; b.bar = bar; b.x = xb_xcc_id(); b.st = st;
    if (threadIdx.x == 0) (void)xb_add(&bar[XB_XCNT(b.x)], 1u);
    return b;
}
__device__ __forceinline__ void xcd_barrier_complete(unsigned* bar, unsigned x, unsigned& nloc, unsigned& nx) {
    const unsigned G = gridDim.x * gridDim.y * gridDim.z;
    unsigned sum, cnt, mine, sp = 0u;
    for (;;) {
        sum = 0u; cnt = 0u; mine = 0u;
#pragma unroll
        for (unsigned j = 0; j < 16; ++j) { const unsigned c = xb_ld(&bar[XB_XCNT(j)]); sum += c; cnt += (c > 0u) ? 1u : 0u; mine = (j == x) ? c : mine; }
        if (sum == G) break;
        __builtin_amdgcn_s_sleep(1);
        if ((++sp & 255u) == 0u) { if (xb_ld(&bar[XB_TMO])) break; if (sp > XB_SPIN_CAP) { atomicAdd(&bar[XB_TMO], 1u); break; } }
    }
    nloc = mine > 0u ? mine : 1u; nx = cnt > 0u ? cnt : 1u;
}

__device__ __forceinline__ void xcd_barrier(const XcdBarrier& b) {
    asm volatile("s_waitcnt vmcnt(0)" ::: "memory");
    __syncthreads();
    if (threadIdx.x == 0) {
        unsigned* bar = b.bar;
        __builtin_amdgcn_s_waitcnt(0);
        unsigned nloc = b.st[0], nx = b.st[1];
        if (nloc == 0u) { xcd_barrier_complete(bar, b.x, nloc, nx); b.st[0] = nloc; b.st[1] = nx; }
        const unsigned old = xb_add(&bar[XB_XSUB(b.x)], 1u);
        const unsigned gen = old / nloc;
        if (old + 1u == (gen + 1u) * nloc) {
            __builtin_amdgcn_fence(__ATOMIC_RELEASE, "agent");
            asm volatile("s_waitcnt vmcnt(0)" ::: "memory");
            const unsigned og = xb_add(&bar[XB_TOP], 1u);
            const unsigned tg = og / nx;
            if (og + 1u == (tg + 1u) * nx) xb_add(&bar[XB_TOPGEN], 1u);
            else XB_SPIN(xb_ld(&bar[XB_TOPGEN]) == tg, bar);
            __builtin_amdgcn_fence(__ATOMIC_ACQUIRE, "agent");
            xb_add(&bar[XB_XGEN(b.x)], 1u);
            asm volatile("s_waitcnt vmcnt(0)" ::: "memory");
        } else {
            XB_SPIN(xb_ld(&bar[XB_XGEN(b.x)]) == gen, bar);
            __builtin_amdgcn_fence(__ATOMIC_ACQUIRE, "agent");
            asm volatile("s_waitcnt vmcnt(0)" ::: "memory");
        }
    }
    __syncthreads();
}

struct Args { const float* in[28]; float* out; unsigned char* ws; int ph_lo, ph_hi; };
enum { I_X = 0, I_C, I_CTX, I_CCTX, I_ADAW, I_ADAB, I_EVWIN, I_EVGB, I_EVQG, I_EVKG, I_EVHG, I_EVWOUT, I_EVFG, I_EVFU, I_EVFD,
       I_ODWIN, I_ODQG, I_ODKG, I_LQ1, I_LK1, I_LQ2, I_LK2, I_ODSG, I_ODWOUT, I_ROUTER, I_EXG, I_EXU, I_EXD };

__device__ __forceinline__ void transpose_item(const float* W, int ldw, int nvalid, int K, bf16* WT, int mode, int item, int nblk, LAS float* scr, int lane) {
    const int kb = item / nblk, nb = item % nblk, k0 = 64 * kb, n0 = 32 * nb;
    const int kr = lane >> 3, c4 = (lane & 7) * 4; const bool ok = n0 + c4 < nvalid;
#pragma unroll
    for (int i = 0; i < 8; ++i) { const f32x4 x = ok ? *(const f32x4*)(W + (size_t)(k0 + 8 * i + kr) * ldw + n0 + c4) : (f32x4){0.f, 0.f, 0.f, 0.f};
        LAS float* sp = scr + (8 * i + kr) * 33 + c4; sp[0] = x.x; sp[1] = x.y; sp[2] = x.z; sp[3] = x.w; }
    LDS_WAIT(); asm volatile("" ::: "memory");
    const int c = lane & 7;
#pragma unroll
    for (int j = 0; j < 4; ++j) { const int n = (lane >> 3) + 8 * j; const LAS float* s = scr + (8 * c) * 33 + n;
        u32x4 o; o.x = pk2(s[0 * 33], s[1 * 33]); o.y = pk2(s[2 * 33], s[3 * 33]); o.z = pk2(s[4 * 33], s[5 * 33]); o.w = pk2(s[6 * 33], s[7 * 33]);
        const int ns = n0 + n; const int dr = mode == 0 ? ns : (256 * (ns >> 7) + 128 * (mode - 1) + (ns & 127));
        *(u32x4*)(WT + (size_t)dr * K + k0 + 8 * c) = o; }
    LDS_WAIT(); asm volatile("" ::: "memory");
}
__device__ __forceinline__ void transpose_item_fp8(const float* W, int ldw, int K, unsigned char* WT8, float scale, int mode, int item, int nblk, LAS float* scr, int lane) {
    const int kb = item / nblk, nb = item % nblk, k0 = 128 * kb, n0 = 32 * nb;
    const int kr = lane >> 3, c4 = (lane & 7) * 4;
#pragma unroll
    for (int i = 0; i < 16; ++i) { const f32x4 x = *(const f32x4*)(W + (size_t)(k0 + 8 * i + kr) * ldw + n0 + c4) * scale;
        LAS float* sp = scr + (8 * i + kr) * 33 + c4; sp[0] = x.x; sp[1] = x.y; sp[2] = x.z; sp[3] = x.w; }
    LDS_WAIT(); asm volatile("" ::: "memory");
    const int c = lane & 7;
#pragma unroll
    for (int j = 0; j < 4; ++j) { const int n = (lane >> 3) + 8 * j; const LAS float* sp = scr + (16 * c) * 33 + n;
        u32x4 o; o.x = pg8::pk4_fp8(sp[0 * 33], sp[1 * 33], sp[2 * 33], sp[3 * 33]); o.y = pg8::pk4_fp8(sp[4 * 33], sp[5 * 33], sp[6 * 33], sp[7 * 33]);
        o.z = pg8::pk4_fp8(sp[8 * 33], sp[9 * 33], sp[10 * 33], sp[11 * 33]); o.w = pg8::pk4_fp8(sp[12 * 33], sp[13 * 33], sp[14 * 33], sp[15 * 33]);
        const int ns = n0 + n; const int dr = mode == 0 ? ns : (256 * (ns >> 7) + 128 * (mode - 1) + (ns & 127));
        *(u32x4*)(WT8 + (size_t)dr * K + k0 + 16 * c) = o; }
    LDS_WAIT(); asm volatile("" ::: "memory");
}
__device__ __forceinline__ float silu_h(float x) { return x / (1.0f + expf(-x)); }
__device__ __forceinline__ void p0_prologue(const Args& a, LAS unsigned char* lds, int tid, int lane, int wave, int bid, int G) {
    unsigned char* ws = a.ws;
    LAS float* scr = (LAS float*)(lds + wave * 16896);
    const int gw = bid * NWAVES + wave, NGW = G * NWAVES;
    constexpr int J1 = 32 * (EV_NP / 32), J2 = 32 * 64, J3 = 32 * (FFD / 32), J4 = (FFD / 64) * 64, J5 = 32 * (OD_LD / 32), J6 = 32 * 64, J7 = 8 * (DM / 128) * (FFE / 32), J8 = 8 * (FFE / 128) * 64;
    constexpr int NITEMS = J1 + J2 + 2 * J3 + J4 + J5 + J6 + 2 * J7 + J8;
    { float* MOD = (float*)(ws + WS_MOD); LAS float* sv = (LAS float*)lds; LAS float* part = sv + 4096;
      for (int k = tid; k < DM; k += 512) { sv[k] = silu_h(a.in[I_C][k]); sv[DM + k] = silu_h(a.in[I_CCTX][k]); }
      __syncthreads();
      for (int it = bid; it < 192; it += G) {
          const int l = it / 96, cb = it % 96, col = cb * 128 + (lane & 31) * 4, kr = lane >> 5;
          f32x4 ac = {0.f, 0.f, 0.f, 0.f}, ax = {0.f, 0.f, 0.f, 0.f};
          const float* wp = a.in[I_ADAW] + ((size_t)l * DM + wave * 256 + kr) * 12288 + col;
#pragma unroll 8
          for (int i = 0; i < 128; ++i) { const f32x4 wv = *(const f32x4*)(wp + (size_t)(2 * i) * 12288); const int k = wave * 256 + 2 * i + kr; ac += wv * sv[k]; ax += wv * sv[DM + k]; }
          const int pi = (wave * 2 + kr) * 2;
          *(LAS f32x4*)(part + (pi + 0) * 128 + (lane & 31) * 4) = ac; *(LAS f32x4*)(part + (pi + 1) * 128 + (lane & 31) * 4) = ax;
          __syncthreads();
          if (tid < 256) { const int kind = tid >> 7, cr = tid & 127; float sum = a.in[I_ADAB][l * 12288 + cb * 128 + cr];
#pragma unroll
              for (int q = 0; q < 16; ++q) sum += part[(q * 2 + kind) * 128 + cr];
              MOD[(l * 2 + kind) * 12288 + cb * 128 + cr] = sum; }
          __syncthreads();
      }
    }
    for (int it = gw; it < NITEMS; it += NGW) {
        int r = it;
        if (r < J1) { transpose_item(a.in[I_EVWIN], EV_IN, EV_IN, DM, (bf16*)(ws + WS_W_EVIN), 0, r, EV_NP / 32, scr, lane); continue; } r -= J1;
        if (r < J2) { transpose_item(a.in[I_EVWOUT], DM, DM, DM, (bf16*)(ws + WS_W_EVOUT), 0, r, 64, scr, lane); continue; } r -= J2;
        if (r < J3) { transpose_item(a.in[I_EVFG], FFD, FFD, DM, (bf16*)(ws + WS_W_EVGU), 1, r, FFD / 32, scr, lane); continue; } r -= J3;
        if (r < J3) { transpose_item(a.in[I_EVFU], FFD, FFD, DM, (bf16*)(ws + WS_W_EVGU), 2, r, FFD / 32, scr, lane); continue; } r -= J3;
        if (r < J4) { transpose_item(a.in[I_EVFD], DM, DM, FFD, (bf16*)(ws + WS_W_EVDN), 0, r, 64, scr, lane); continue; } r -= J4;
        if (r < J5) { transpose_item(a.in[I_ODWIN], OD_LD, OD_LD, DM, (bf16*)(ws + WS_W_ODIN), 0, r, OD_LD / 32, scr, lane); continue; } r -= J5;
        if (r < J6) { transpose_item(a.in[I_ODWOUT], DM, DM, DM, (bf16*)(ws + WS_W_ODOUT), 0, r, 64, scr, lane); continue; } r -= J6;
        if (r < J7) { const int e = r / (J7 / 8), rr = r % (J7 / 8); transpose_item_fp8(a.in[I_EXG] + (size_t)e * DM * FFE, FFE, DM, (unsigned char*)(ws + WS_W_EXGU) + (size_t)e * 2 * FFE * DM, EXGU_SCALE, 1, rr, FFE / 32, scr, lane); continue; } r -= J7;
        if (r < J7) { const int e = r / (J7 / 8), rr = r % (J7 / 8); transpose_item_fp8(a.in[I_EXU] + (size_t)e * DM * FFE, FFE, DM, (unsigned char*)(ws + WS_W_EXGU) + (size_t)e * 2 * FFE * DM, EXGU_SCALE, 2, rr, FFE / 32, scr, lane); continue; } r -= J7;
        { const int e = r / (J8 / 8), rr = r % (J8 / 8); transpose_item_fp8(a.in[I_EXD] + (size_t)e * FFE * DM, DM, FFE, (unsigned char*)(ws + WS_W_EXDN) + (size_t)e * DM * FFE, EXDN_SCALE, 0, rr, 64, scr, lane); }
    }
    { const int g = bid * 512 + tid;
      if (g < 8192) { const int pos = g >> 5, f = g & 31; const float inv = exp2f(-(float)f * (13.287712379549449f / 32.0f)); const float ang = (float)pos * inv;
          double rev = (double)ang * 0.15915494309189535; rev -= floor(rev); const float rf = (float)rev;
          float* T = (float*)(ws + WS_TAB); T[2 * g] = __builtin_amdgcn_cosf(rf); T[2 * g + 1] = __builtin_amdgcn_sinf(rf); } }
}

template <bool ROUTER>
__device__ __forceinline__ void phase_norm(const Args& a, LAS unsigned char* lds, int tid, int lane, int wave, int bid, int G,
                                           const float* src_lat, const float* src_ctx, int nrows, int layer, int which, const float* part, int nparts, float* ctx_wb) {
    unsigned char* ws = a.ws; bf16* H = (bf16*)(ws + WS_H); const float* MOD = (const float*)(ws + WS_MOD) + layer * 2 * 12288;
    LAS float* RT = (LAS float*)lds;
    LAS unsigned* lcnt = (LAS unsigned*)(lds + 65536); LAS unsigned* lgb = lcnt + 8; LAS unsigned* lpair = lcnt + 16;
    if (ROUTER) { int tidr = tid; asm volatile("" : "+v"(tidr));     for (int idx = tidr; idx < DM * 8; idx += 512) { RT[(idx & 7) * DM + (idx >> 3)] = a.in[I_ROUTER][idx]; } if (tid < 8) lcnt[tid] = 0u; __syncthreads(); }
    const int gw = bid * NWAVES + wave, NGW = G * NWAVES;
    for (int row = gw; row < nrows; row += NGW) {
        const bool isc = row >= SEQ;
        const f32x4* xr = (const f32x4*)(isc ? src_ctx + (size_t)(row - SEQ) * DM : src_lat + (size_t)row * DM) + lane;
        const f32x4* sh = (const f32x4*)(MOD + (isc ? 12288 : 0) + which * 3 * DM) + lane; const f32x4* sc = sh + DM / 4;
        f32x4 v[8]; float ss = 0.f;
#pragma unroll
        for (int j = 0; j < 8; ++j) v[j] = xr[64 * j];
        if (isc && nparts > 0) {
            for (int p = 0; p < nparts; ++p) { const f32x4* pr = (const f32x4*)(part + ((size_t)p * 256 + (row - SEQ)) * DM) + lane;
#pragma unroll
                for (int j = 0; j < 8; ++j) v[j] += pr[64 * j]; }
            if (ctx_wb) { f32x4* wb = (f32x4*)(ctx_wb + (size_t)(row - SEQ) * DM) + lane;
#pragma unroll
                for (int j = 0; j < 8; ++j) wb[64 * j] = v[j]; }
        }
#pragma unroll
        for (int j = 0; j < 8; ++j) ss += (v[j].x * v[j].x + v[j].y * v[j].y) + (v[j].z * v[j].z + v[j].w * v[j].w);
        const float rstd = 1.0f / sqrtf(wave_sum(ss) * (1.0f / DM) + EPS);
        float lg[8];
        if (ROUTER) {
#pragma unroll
            for (int e = 0; e < 8; ++e) lg[e] = 0.f; }
        u32x2* o8 = (u32x2*)(H + (size_t)row * DM) + lane;
#pragma unroll
        for (int j = 0; j < 8; ++j) { const f32x4 s4 = sc[64 * j], h4 = sh[64 * j]; const f32x4 hv = v[j] * rstd * (s4 + 1.0f) + h4;
            u32x2 w; w.x = pk2(hv.x, hv.y); w.y = pk2(hv.z, hv.w); o8[64 * j] = w; v[j] = hv; }
        if (ROUTER) {
#pragma unroll
            for (int e = 0; e < 8; ++e) { float s = 0.f;
#pragma unroll
                for (int j = 0; j < 8; ++j) { const f32x4 rt = *(const LAS f32x4*)(RT + e * DM + 256 * j + 4 * lane); s += (v[j].x * rt.x + v[j].y * rt.y) + (v[j].z * rt.z + v[j].w * rt.w); }
                lg[e] = s; asm volatile("" ::: "memory"); } }
        if (ROUTER) {
#pragma unroll
            for (int e = 0; e < 8; ++e) lg[e] = wave_sum(lg[e]);
            if (lane == 0) {
                int e0 = 0; float v0 = lg[0];
#pragma unroll
                for (int e = 1; e < 8; ++e) if (lg[e] > v0) { v0 = lg[e]; e0 = e; }
                int e1 = -1; float v1 = -3.0e38f;
#pragma unroll
                for (int e = 0; e < 8; ++e) if (e != e0 && lg[e] > v1) { v1 = lg[e]; e1 = e; }
                const float w0 = 1.0f / (1.0f + expf(v1 - v0)), w1 = 1.0f - w0;
                const unsigned s0 = __hip_atomic_fetch_add(lcnt + e0, 1u, __ATOMIC_RELAXED, __HIP_MEMORY_SCOPE_WORKGROUP), s1 = __hip_atomic_fetch_add(lcnt + e1, 1u, __ATOMIC_RELAXED, __HIP_MEMORY_SCOPE_WORKGROUP);
                const int li = ((row - gw) / NGW) * NWAVES + wave; LAS unsigned* lp = lpair + li * 4; lp[0] = (unsigned)e0; lp[1] = (unsigned)e1; lp[2] = s0; lp[3] = s1;
                unsigned* tk = (unsigned*)(ws + WS_TOK) + (size_t)row * 6;
                tk[0] = (unsigned)e0; tk[1] = (unsigned)e1; tk[4] = __float_as_uint(w0); tk[5] = __float_as_uint(w1);
            }
        }
    }
    if (ROUTER) {
        __syncthreads();
        if (tid < 8) lgb[tid] = __hip_atomic_fetch_add((unsigned*)(ws + WS_CTL) + CW_CNT + tid, lcnt[tid], __ATOMIC_RELAXED, __HIP_MEMORY_SCOPE_AGENT);
        __syncthreads();
        const int nloc = (nrows - bid * NWAVES + NGW - 1) / NGW;
        if (tid < nloc * NWAVES) { const int w_ = tid % NWAVES, i_ = tid / NWAVES, row = bid * NWAVES + w_ + i_ * NGW;
            if (row < nrows) { const LAS unsigned* lp = lpair + tid * 4; unsigned* tk = (unsigned*)(ws + WS_TOK) + (size_t)row * 6; tk[2] = lgb[lp[0]] + lp[2]; tk[3] = lgb[lp[1]] + lp[3]; } }
    }
}

__device__ __forceinline__ int seq_row(int dir, int c, int pos) { return dir == 0 ? (c < 4 ? SEQ + 64 * c + pos : 64 * (c - 4) + pos) : (c < 4 ? SEQ + 255 - 64 * c - pos : SEQ - 1 - 64 * (c - 4) - pos); }
__device__ __forceinline__ int blk_row(int dir, int c) { return dir == 0 ? (c < 4 ? SEQ + 64 * c : 64 * (c - 4)) : (c < 4 ? SEQ + 64 * (3 - c) : 64 * (259 - c)); }
template <int NQ, int NK, bool CTXQ, bool GATES>
__device__ __forceinline__ void phase_qknorm(const Args& a, int lane, int wave, int bid, int G, int ld, int qcol0, int kcol0, const float* qg, const float* kg) {
    unsigned char* ws = a.ws; bf16* P = (bf16*)(ws + WS_PROJ); const float* TAB = (const float*)(ws + WS_TAB);
    const int gw = bid * NWAVES + wave, NGW = G * NWAVES;
    if (GATES) {
        const float* Gt = (const float*)(ws + WS_G); float* GP = (float*)(ws + WS_GP); float* GSC = (float*)(ws + WS_GS) + 8 * NCH * 4;
        for (int it = gw; it < 8 * NCH; it += NGW) {
            const int dh = it / NCH, c = it % NCH, dir = dh >> 2, head = dh & 3;
            const int row = seq_row(dir, c, lane);
            const float gi = Gt[(size_t)row * 16 + dir * 8 + head], gf = Gt[(size_t)row * 16 + dir * 8 + 4 + head];
            const float fc = fminf(gf, 0.f) - log1pf(expf(-fabsf(gf)));
            float bc = fc;
#pragma unroll
            for (int o = 1; o < 64; o <<= 1) { const float t = __shfl_up(bc, o); if (lane >= o) bc += t; }
            const float av = gi - bc; float pm = av;
#pragma unroll
            for (int o = 1; o < 64; o <<= 1) { const float t = __shfl_up(pm, o); if (lane >= o) pm = fmaxf(pm, t); }
            float* gp = GP + (size_t)it * 192; gp[lane] = av; gp[64 + lane] = pm; gp[128 + lane] = bc;
            const float blast = __shfl(bc, 63), pml = __shfl(pm, 63);
            if (lane == 0) { GSC[it * 2] = blast; GSC[it * 2 + 1] = blast + pml; }
        }
    }
    const float q0 = qg[2 * lane], q1 = qg[2 * lane + 1], k0 = kg[2 * lane], k1 = kg[2 * lane + 1];
    for (int t = gw; t < NTOK; t += NGW) {
        const bool lat = t < SEQ; unsigned* base = (unsigned*)(P + (size_t)t * ld) + lane;
        float c = 1.f, s = 0.f;
        if (lat) { const int pos = lane < 32 ? (t >> 6) : (t & 63); const float* tp = TAB + 2 * (pos * 32 + (lane & 31)); c = tp[0]; s = tp[1]; }
        const bool doq = lat || CTXQ;
        unsigned uq[NQ], uk[NK];
        if (doq) {
#pragma unroll
            for (int i = 0; i < NQ; ++i) uq[i] = base[(qcol0 + i * 128) >> 1]; }
#pragma unroll
        for (int i = 0; i < NK; ++i) uk[i] = base[(kcol0 + i * 128) >> 1];
        if (doq) {
#pragma unroll
            for (int i = 0; i < NQ; ++i) { const float x0 = bf2f(uq[i] & 0xffffu), x1 = bf2f(uq[i] >> 16);
                const float rstd = 1.0f / sqrtf(wave_sum(x0 * x0 + x1 * x1) * (1.0f / 128.0f) + EPS); const float y0 = x0 * rstd * q0, y1 = x1 * rstd * q1;
                base[(qcol0 + i * 128) >> 1] = pk2(y0 * c - y1 * s, y0 * s + y1 * c); } }
#pragma unroll
        for (int i = 0; i < NK; ++i) { const float x0 = bf2f(uk[i] & 0xffffu), x1 = bf2f(uk[i] >> 16);
            const float rstd = 1.0f / sqrtf(wave_sum(x0 * x0 + x1 * x1) * (1.0f / 128.0f) + EPS); const float y0 = x0 * rstd * k0, y1 = x1 * rstd * k1;
            base[(kcol0 + i * 128) >> 1] = pk2(y0 * c - y1 * s, y0 * s + y1 * c); }
    }
}

__device__ __forceinline__ unsigned bfelem(const u32x4& u, int e) { const unsigned w = u[e >> 1]; return (e & 1) ? (w >> 16) : (w & 0xffffu); }
__device__ __forceinline__ void phase_m3(const Args& a, LAS unsigned char* lds, int tid, int lane, int wave, int bid, int G) {
    unsigned char* ws = a.ws; const bf16* P = (const bf16*)(ws + WS_PROJ); const float* GP = (const float*)(ws + WS_GP); const float* GS = (const float*)(ws + WS_GS);
    float* NS = (float*)(ws + WS_NS); bf16* ST = (bf16*)(ws + WS_BIG);
    LAS bf16* KwT = (LAS bf16*)lds; LAS bf16* VT = (LAS bf16*)(lds + 18432); LAS float* wts = (LAS float*)(lds + 18432 + 36864);
    const int l31 = lane & 31, hi = lane >> 5;
    LAS float* gsc = (LAS float*)(lds + 65536); LAS float* gsl = gsc + 8 * NCH * 2;
    { const float* GSC = GS + 8 * NCH * 4; for (int i = tid; i < 8 * NCH * 2; i += 512) gsc[i] = GSC[i]; }
    __syncthreads();
    if (lane == 0) { const int dh = wave; float m = -1e30f;
        for (int c = 0; c < NCH; ++c) { const float b = gsc[(dh * NCH + c) * 2], mn = fmaxf(b + m, gsc[(dh * NCH + c) * 2 + 1]); LAS float* g = gsl + (dh * NCH + c) * 4; g[0] = m; g[1] = mn; g[2] = expf(b + m - mn); g[3] = b; m = mn; } }
    __syncthreads();
    if (bid == 0) { float* GSw = (float*)(ws + WS_GS); for (int i = tid; i < 8 * NCH * 4; i += 512) GSw[i] = gsl[i]; }
    u32x4 pk0, pk1, pv[4]; float pgp = 0.f;
#define M3_PREFETCH(itn) do { const int dh_ = (itn) / NCH, c_ = (itn) % NCH, dir_ = dh_ >> 2, head_ = dh_ & 3, r0_ = blk_row(dir_, c_); \
        { const int row = tid >> 3, cc = (tid & 7) * 16; const bf16* src = P + (size_t)(r0_ + row) * EV_LD + 2048 + head_ * 128 + cc; pk0 = *(const u32x4*)src; pk1 = *(const u32x4*)(src + 8); } \
        { const int row = tid >> 3, cc = (tid & 7) * 32; const bf16* src = P + (size_t)(r0_ + row) * EV_LD + 2560 + head_ * 256 + cc; \
          _Pragma("unroll") for (int q = 0; q < 4; ++q) pv[q] = *(const u32x4*)(src + 8 * q); } \
        if (tid < 64) { const int pos = dir_ ? 63 - tid : tid; pgp = GP[(size_t)(dh_ * NCH + c_) * 192 + pos]; } } while (0)
    if (bid < 8 * NCH) M3_PREFETCH(bid);
    for (int it = bid; it < 8 * NCH; it += G) {
        const int dh = it / NCH, c = it % NCH;
        __syncthreads();
        if (tid < 64) { const LAS float* gs = gsl + (dh * NCH + c) * 4; wts[tid] = expf(gs[3] + pgp - gs[1]); }
        __syncthreads();
        { const int row = tid >> 3, cc = (tid & 7) * 16; const float w = wts[row];
#pragma unroll
          for (int e = 0; e < 8; ++e) { KwT[(cc + e) * 72 + row] = (bf16)f2bf(w * bf2f(bfelem(pk0, e))); KwT[(cc + 8 + e) * 72 + row] = (bf16)f2bf(w * bf2f(bfelem(pk1, e))); } }
        { const int row = tid >> 3, cc = (tid & 7) * 32;
#pragma unroll
          for (int q = 0; q < 4; ++q) {
#pragma unroll
              for (int e = 0; e < 8; ++e) VT[(cc + 8 * q + e) * 72 + row] = (bf16)bfelem(pv[q], e); } }
        __syncthreads();
        if (it + G < 8 * NCH) M3_PREFETCH(it + G);
        f32x16 acc[4];
#pragma unroll
        for (int dt = 0; dt < 4; ++dt)
#pragma unroll
            for (int r = 0; r < 16; ++r) acc[dt][r] = 0.f;
#pragma unroll
        for (int ks = 0; ks < 4; ++ks) { const bf16x8 bfr = *(const LAS bf16x8*)(VT + (wave * 32 + l31) * 72 + ks * 16 + 8 * hi);
#pragma unroll
            for (int dt = 0; dt < 4; ++dt) { const bf16x8 afr = *(const LAS bf16x8*)(KwT + (dt * 32 + l31) * 72 + ks * 16 + 8 * hi);
                acc[dt] = __builtin_amdgcn_mfma_f32_32x32x16_bf16(afr, bfr, acc[dt], 0, 0, 0); } }
        bf16* dst = ST + (size_t)(dh * NCH + c) * 32768 + (size_t)(wave * 32 + l31) * 128;
#pragma unroll
        for (int dt = 0; dt < 4; ++dt)
#pragma unroll
            for (int g = 0; g < 4; ++g) { u32x2 w; w.x = pk2(acc[dt][4 * g], acc[dt][4 * g + 1]); w.y = pk2(acc[dt][4 * g + 2], acc[dt][4 * g + 3]); *(u32x2*)(dst + dt * 32 + 8 * g + 4 * hi) = w; }
        if (tid < 128) { float s = 0.f;
#pragma unroll 8
            for (int q = 0; q < 64; ++q) s += bf2f(KwT[tid * 72 + q]);
            NS[(size_t)(dh * NCH + c) * 128 + tid] = s; }
    }
#undef M3_PREFETCH
}
__device__ __forceinline__ void phase_m4(const Args& a, int tid, int bid, int G) {
    unsigned char* ws = a.ws; const float* GS = (const float*)(ws + WS_GS); float* NS = (float*)(ws + WS_NS); unsigned* ST = (unsigned*)(ws + WS_BIG);
    constexpr int NU = 20;
    for (int q = bid; q < 256; q += G) {
        const int dh = q >> 5; unsigned* base = ST + (size_t)dh * NCH * 16384 + (q & 31) * 512 + tid; const float* gs = GS + (size_t)dh * NCH * 4 + 2;
        float c0 = 0.f, c1 = 0.f;
#pragma unroll 1
        for (int c = 0; c < NCH; c += NU) { unsigned u[NU]; float ad[NU];
#pragma unroll
            for (int i = 0; i < NU; ++i) { u[i] = base[(size_t)(c + i) * 16384]; ad[i] = gs[(c + i) * 4]; }
#pragma unroll
            for (int i = 0; i < NU; ++i) { base[(size_t)(c + i) * 16384] = pk2(c0, c1); c0 = ad[i] * c0 + bf2f(u[i] & 0xffffu); c1 = ad[i] * c1 + bf2f(u[i] >> 16); } }
    }
    for (int p = bid * 512 + tid; p < 8 * 128; p += G * 512) {
        const int dh = p >> 7; float* base = NS + (size_t)dh * NCH * 128 + (p & 127); const float* gs = GS + (size_t)dh * NCH * 4 + 2; float n = 0.f;
#pragma unroll 1
        for (int c = 0; c < NCH; c += NU) { float d[NU], ad[NU];
#pragma unroll
            for (int i = 0; i < NU; ++i) { d[i] = base[(size_t)(c + i) * 128]; ad[i] = gs[(c + i) * 4]; }
#pragma unroll
            for (int i = 0; i < NU; ++i) { base[(size_t)(c + i) * 128] = n; n = ad[i] * n + d[i]; } }
    }
}
__device__ __forceinline__ void phase_m5(const Args& a, LAS unsigned char* lds, int tid, int lane, int wave, int bid, int G) {
    size_t vz = 0; asm volatile("" : "+v"(vz));
    unsigned char* ws = a.ws; const bf16* P = (const bf16*)(ws + WS_PROJ); const float* GP = (const float*)(ws + WS_GP + vz); const float* GS = (const float*)(ws + WS_GS + vz);
    const float* NS = (const float*)(ws + WS_NS + vz); const bf16* ST = (const bf16*)(ws + WS_BIG + vz); bf16* MIX = (bf16*)(ws + WS_MIX + vz);
    constexpr float SC = 0.088388347648318440f;
    LAS bf16* Qs = (LAS bf16*)lds; LAS bf16* Ks = (LAS bf16*)(lds + 17408); LAS bf16* VT = (LAS bf16*)(lds + 34816); LAS float* Hs = (LAS float*)lds;
    LAS bf16* Ps = (LAS bf16*)(lds + 71680); LAS float* arr = (LAS float*)(lds + 80896);
    const int l31 = lane & 31, hi = lane >> 5;
    u32x4 pq0, pq1, pk0, pk1, pv[4];
#define M5_PREFETCH(itn) do { const int head_ = (itn) / NCH, b_ = (itn) % NCH, r0_ = b_ < 256 ? 64 * b_ : SEQ + 64 * (b_ - 256); \
        { const int row = tid >> 3, cc = (tid & 7) * 16; const bf16* sq = P + (size_t)(r0_ + row) * EV_LD + 1536 + head_ * 128 + cc; const bf16* sk = sq + 512; \
          pq0 = *(const u32x4*)sq; pq1 = *(const u32x4*)(sq + 8); pk0 = *(const u32x4*)sk; pk1 = *(const u32x4*)(sk + 8); } \
        { const int row = tid >> 3, cc = (tid & 7) * 32; const bf16* src = P + (size_t)(r0_ + row) * EV_LD + 2560 + head_ * 256 + cc; \
          _Pragma("unroll") for (int q = 0; q < 4; ++q) pv[q] = *(const u32x4*)(src + 8 * q); } } while (0)
    if (bid < 4 * NCH) M5_PREFETCH(bid);
    for (int it = bid; it < 4 * NCH; it += G) {
        const int head = it / NCH, b = it % NCH, r0 = b < 256 ? 64 * b : SEQ + 64 * (b - 256);
        __syncthreads();
        { const int row = tid >> 3, cc = (tid & 7) * 16;
          *(LAS u32x4*)(Qs + row * 136 + cc) = pq0; *(LAS u32x4*)(Qs + row * 136 + cc + 8) = pq1;
          *(LAS u32x4*)(Ks + row * 136 + cc) = pk0; *(LAS u32x4*)(Ks + row * 136 + cc + 8) = pk1; }
        { const int row = tid >> 3, cc = (tid & 7) * 32;
#pragma unroll
          for (int q = 0; q < 4; ++q) {
#pragma unroll
              for (int e = 0; e < 8; ++e) VT[(cc + 8 * q + e) * 72 + row] = (bf16)bfelem(pv[q], e); } }
        if (it + G < 4 * NCH) M5_PREFETCH(it + G);
        f32x16 hsum[2];
#pragma unroll
        for (int rt = 0; rt < 2; ++rt)
#pragma unroll
            for (int r = 0; r < 16; ++r) hsum[rt][r] = 0.f;
#pragma unroll 1
        for (int dir = 0; dir < 2; ++dir) {
            const int c = dir == 0 ? (b < 256 ? 4 + b : b - 256) : (b < 256 ? 259 - b : 3 - (b - 256)); const int dh = dir * 4 + head;
            const bf16* ctp = ST + (size_t)(dh * NCH + c) * 32768 + (size_t)(wave * 32 + l31) * 128 + 8 * hi;
            bf16x8 ctf[8];
#pragma unroll
            for (int ks = 0; ks < 8; ++ks) ctf[ks] = *(const bf16x8*)(ctp + 16 * ks);
            if (tid < 64) { const int pos = dir ? 63 - tid : tid; const float* gp = GP + (size_t)(dh * NCH + c) * 192; const float ms = GS[(size_t)(dh * NCH + c) * 4];
                const float av = gp[pos], pmv = gp[64 + pos], bc = gp[128 + pos], M = fmaxf(ms, pmv);
                arr[tid] = av; arr[64 + tid] = M; arr[128 + tid] = expf(ms - M); arr[192 + tid] = expf(-bc - M); }
            else if (tid < 192) arr[384 + tid - 64] = NS[(size_t)(dh * NCH + c) * 128 + tid - 64];
            __syncthreads();
            if (wave < 4) { const int rt = wave >> 1, ct = wave & 1; f32x16 s;
#pragma unroll
                for (int r = 0; r < 16; ++r) s[r] = 0.f;
#pragma unroll
                for (int ks = 0; ks < 8; ++ks) { const bf16x8 af = *(const LAS bf16x8*)(Qs + (rt * 32 + l31) * 136 + 16 * ks + 8 * hi), bfr = *(const LAS bf16x8*)(Ks + (ct * 32 + l31) * 136 + 16 * ks + 8 * hi);
                    s = __builtin_amdgcn_mfma_f32_32x32x16_bf16(af, bfr, s, 0, 0, 0); }
                const int sidx = ct * 32 + l31; const float as = arr[sidx];
#pragma unroll
                for (int r = 0; r < 16; ++r) { const int j = rt * 32 + (r & 3) + 8 * (r >> 2) + 4 * hi; const bool valid = dir ? (sidx >= j) : (sidx <= j);
                    const float p = valid ? s[r] * SC * expf(as - arr[64 + j]) : 0.f; Ps[j * 72 + sidx] = (bf16)f2bf(p); }
            } else if (wave == 4) { float qn = 0.f;
#pragma unroll 8
                for (int d = 0; d < 128; ++d) qn += bf2f(Qs[lane * 136 + d]) * arr[384 + d];
                arr[256 + lane] = qn * SC; }
            __syncthreads();
            f32x16 inter[2], intra[2];
#pragma unroll
            for (int rt = 0; rt < 2; ++rt)
#pragma unroll
                for (int r = 0; r < 16; ++r) { inter[rt][r] = 0.f; intra[rt][r] = 0.f; }
#pragma unroll
            for (int rt = 0; rt < 2; ++rt)
#pragma unroll
                for (int ks = 0; ks < 8; ++ks) { const bf16x8 af = *(const LAS bf16x8*)(Qs + (rt * 32 + l31) * 136 + 16 * ks + 8 * hi); inter[rt] = __builtin_amdgcn_mfma_f32_32x32x16_bf16(af, ctf[ks], inter[rt], 0, 0, 0); }
#pragma unroll
            for (int ks = 0; ks < 4; ++ks) { const bf16x8 bfr = *(const LAS bf16x8*)(VT + (wave * 32 + l31) * 72 + 16 * ks + 8 * hi);
#pragma unroll
                for (int rt = 0; rt < 2; ++rt) { const bf16x8 af = *(const LAS bf16x8*)(Ps + (rt * 32 + l31) * 72 + 16 * ks + 8 * hi); intra[rt] = __builtin_amdgcn_mfma_f32_32x32x16_bf16(af, bfr, intra[rt], 0, 0, 0); } }
            if (wave == 0) { float rs = 0.f;
#pragma unroll 8
                for (int q = 0; q < 64; ++q) rs += bf2f(Ps[lane * 72 + q]);
                const float den = arr[128 + lane] * arr[256 + lane] + rs; arr[320 + lane] = 1.0f / fmaxf(fabsf(den), arr[192 + lane]); }
            __syncthreads();
#pragma unroll
            for (int rt = 0; rt < 2; ++rt)
#pragma unroll
                for (int r = 0; r < 16; ++r) { const int j = rt * 32 + (r & 3) + 8 * (r >> 2) + 4 * hi; hsum[rt][r] += (arr[128 + j] * SC * inter[rt][r] + intra[rt][r]) * arr[320 + j]; }
            __syncthreads();
        }
#pragma unroll
        for (int rt = 0; rt < 2; ++rt)
#pragma unroll
            for (int r = 0; r < 16; ++r) Hs[(rt * 32 + (r & 3) + 8 * (r >> 2) + 4 * hi) * 260 + wave * 32 + l31] = hsum[rt][r];
        __syncthreads();
        { const int j = tid >> 3, cg = tid & 7; float v[32]; float ss = 0.f;
#pragma unroll
          for (int q = 0; q < 8; ++q) { const f32x4 t = *(const LAS f32x4*)(Hs + j * 260 + cg * 32 + 4 * q); v[4 * q] = t.x; v[4 * q + 1] = t.y; v[4 * q + 2] = t.z; v[4 * q + 3] = t.w; ss += (t.x * t.x + t.y * t.y) + (t.z * t.z + t.w * t.w); }
          ss += __shfl_xor(ss, 1); ss += __shfl_xor(ss, 2); ss += __shfl_xor(ss, 4);
          const float rstd = 1.0f / sqrtf(ss * (1.0f / 256.0f) + EPS);
          const bf16* op = P + (size_t)(r0 + j) * EV_LD + 3584 + head * 256 + cg * 32; const float* hg = (const float*)((const unsigned char*)a.in[I_EVHG] + vz) + head * 256 + cg * 32;
          bf16* mp = MIX + (size_t)(r0 + j) * DM + 1024 + head * 256 + cg * 32;
#pragma unroll
          for (int q = 0; q < 4; ++q) { const u32x4 ou = *(const u32x4*)(op + 8 * q); float o[8];
#pragma unroll
              for (int e = 0; e < 8; ++e) { const float og = bf2f(bfelem(ou, e)); o[e] = v[8 * q + e] * rstd * hg[8 * q + e] / (1.0f + expf(-og)); }
              u32x4 w; w.x = pk2(o[0], o[1]); w.y = pk2(o[2], o[3]); w.z = pk2(o[4], o[5]); w.w = pk2(o[6], o[7]); *(u32x4*)(mp + 8 * q) = w; } }
    }
#undef M5_PREFETCH
}

__device__ __forceinline__ void phase_combine(const Args& a, int lane, int wave, int bid, int G) {
    unsigned char* ws = a.ws; const float* O1 = (const float*)(ws + WS_BIG); bf16* MIX = (bf16*)(ws + WS_MIX);
    const float lam_init = 0.8f - 0.6f * expf(-0.3f);
    const float d1 = wave_sum(a.in[I_LQ1][lane] * a.in[I_LK1][lane] + a.in[I_LQ1][64 + lane] * a.in[I_LK1][64 + lane]);
    const float d2 = wave_sum(a.in[I_LQ2][lane] * a.in[I_LK2][lane] + a.in[I_LQ2][64 + lane] * a.in[I_LK2][64 + lane]);
    const float lam = expf(d1) - expf(d2) + lam_init;
    const f32x4 sg = *(const f32x4*)(a.in[I_ODSG] + 4 * lane);
    const int gw = bid * NWAVES + wave, NGW = G * NWAVES;
    for (int it = gw; it < SEQ * 8; it += NGW) {
        const int t = it >> 3, h = it & 7; const f32x4* p = (const f32x4*)(O1 + (size_t)t * 4096 + h * 512) + lane;
        const f32x4 o0 = p[0], o1 = p[64]; const f32x4 v = o0 - o1 * lam;
        const float ss = wave_sum((v.x * v.x + v.y * v.y) + (v.z * v.z + v.w * v.w));
        const float r = (1.0f - lam_init) / sqrtf(ss * (1.0f / 256.0f) + EPS);
        const f32x4 y = v * r * sg; u32x2 w; w.x = pk2(y.x, y.y); w.y = pk2(y.z, y.w);
        *((u32x2*)(MIX + (size_t)t * DM + h * 256) + lane) = w;
    }
}
__device__ __forceinline__ void phase_gather(const Args& a, int lane, int wave, int bid, int G) {
    unsigned char* ws = a.ws; const bf16* H = (const bf16*)(ws + WS_H); unsigned char* HP = (unsigned char*)(ws + WS_PROJ);
    const unsigned* cnt = (const unsigned*)(ws + WS_CTL) + CW_CNT; const unsigned* TK = (const unsigned*)(ws + WS_TOK); unsigned* RW = (unsigned*)(ws + WS_ROW);
    unsigned base[8], cn[8]; { unsigned acc = 0;
#pragma unroll
        for (int e = 0; e < 8; ++e) { cn[e] = cnt[e]; base[e] = acc; acc += ((cn[e] + 255u) >> 8) << 8; } }
    const int gw = bid * NWAVES + wave, NGW = G * NWAVES;
    for (int t = gw; t < SEQ; t += NGW) {
        const unsigned* tk = TK + (size_t)t * 6; const u32x4* src = (const u32x4*)(H + (size_t)t * DM) + lane;
        u32x2 v[4];
#pragma unroll
        for (int j = 0; j < 4; ++j) { const u32x4 x = src[64 * j];
            v[j].x = pg8::pk4_fp8(bf2f(x.x & 0xffffu), bf2f(x.x >> 16), bf2f(x.y & 0xffffu), bf2f(x.y >> 16)); v[j].y = pg8::pk4_fp8(bf2f(x.z & 0xffffu), bf2f(x.z >> 16), bf2f(x.w & 0xffffu), bf2f(x.w >> 16)); }
#pragma unroll
        for (int k = 0; k < 2; ++k) { const unsigned e = tk[k], slot = tk[2 + k]; unsigned b = 0;
#pragma unroll
            for (int q = 0; q < 8; ++q) b = (e == (unsigned)q) ? base[q] : b;
            const unsigned dest = b + slot; u32x2* dp = (u32x2*)(HP + (size_t)dest * DM) + lane;
#pragma unroll
            for (int j = 0; j < 4; ++j) dp[64 * j] = v[j];
            if (lane == 0) { RW[2 * dest] = (unsigned)t; RW[2 * dest + 1] = tk[4 + k]; } }
    }
    for (int it = gw; it < 8 * 256; it += NGW) { const int e = it >> 8, pi = it & 255; unsigned b = 0, c = 0;
#pragma unroll
        for (int q = 0; q < 8; ++q) { b = (e == q) ? base[q] : b; c = (e == q) ? cn[q] : c; }
        const unsigned npad = (((c + 255u) >> 8) << 8) - c;
        if ((unsigned)pi < npad) { const unsigned dest = b + c + pi; u32x2* dp = (u32x2*)(HP + (size_t)dest * DM) + lane; const u32x2 z = {0u, 0u};
#pragma unroll
            for (int j = 0; j < 4; ++j) dp[64 * j] = z;
            if (lane == 0) { RW[2 * dest] = 0xffffffffu; RW[2 * dest + 1] = 0u; } }
    }
}

__device__ __forceinline__ void phase_moe_combine(const Args& a, int lane, int wave, int bid, int G) {
    unsigned char* ws = a.ws; const bf16* YP = (const bf16*)(ws + WS_PROJ); const float* SLAB = (const float*)(ws + WS_H); float* OUT = a.out; const float* g2 = (const float*)(ws + WS_MOD) + 2 * 12288 + 5 * DM;
    const unsigned* cnt = (const unsigned*)(ws + WS_CTL) + CW_CNT; const unsigned* TK = (const unsigned*)(ws + WS_TOK);
    unsigned base[8]; unsigned acc = 0; {
#pragma unroll
        for (int e = 0; e < 8; ++e) { base[e] = acc; acc += ((cnt[e] + 255u) >> 8) << 8; } }
    int pm_split, S; pg8::tail_split((int)(acc >> 8), DM / 256, G, FFE / 128, pm_split, S); const int rt = (int)(acc >> 8) - pm_split;
    f32x4 gg[8];
#pragma unroll
    for (int j = 0; j < 8; ++j) gg[j] = *((const f32x4*)g2 + 64 * j + lane);
    const int gw = bid * NWAVES + wave, NGW = G * NWAVES;
    for (int t = gw; t < SEQ; t += NGW) {
        const unsigned* tk = TK + (size_t)t * 6; unsigned b0 = 0, b1 = 0;
#pragma unroll
        for (int q = 0; q < 8; ++q) { b0 = (tk[0] == (unsigned)q) ? base[q] : b0; b1 = (tk[1] == (unsigned)q) ? base[q] : b1; }
        const float w0 = __uint_as_float(tk[4]), w1 = __uint_as_float(tk[5]);
        f32x4* op = (f32x4*)(OUT + (size_t)t * DM) + lane;
        f32x4 y[8];
#pragma unroll
        for (int j = 0; j < 8; ++j) y[j] = (f32x4){0.f, 0.f, 0.f, 0.f};
#pragma unroll
        for (int k = 0; k < 2; ++k) { const unsigned row = (k ? b1 : b0) + tk[2 + k]; const float w = k ? w1 : w0;
            if ((int)(row >> 8) >= pm_split) {
                const unsigned rl = row - (unsigned)pm_split * 256u;
                for (int sidx = 0; sidx < S; ++sidx) { const f32x4* sp = (const f32x4*)(SLAB + ((size_t)sidx * rt * 256 + rl) * DM) + lane;
#pragma unroll
                    for (int j = 0; j < 8; ++j) y[j] += sp[64 * j] * w; }
            } else { const u32x2* yp = (const u32x2*)(YP + (size_t)row * DM) + lane; u32x2 av[8];
#pragma unroll
                for (int j = 0; j < 8; ++j) av[j] = yp[64 * j];
#pragma unroll
                for (int j = 0; j < 8; ++j) { y[j].x += w * bf2f(av[j].x & 0xffffu); y[j].y += w * bf2f(av[j].x >> 16); y[j].z += w * bf2f(av[j].y & 0xffffu); y[j].w += w * bf2f(av[j].y >> 16); } } }
#pragma unroll
        for (int j = 0; j < 8; ++j) op[64 * j] = op[64 * j] + gg[j] * y[j];
    }
}

constexpr int NPH = 23;
__global__ void __launch_bounds__(NWAVES * 64, 2) __attribute__((amdgpu_num_vgpr(248))) mega_fwd(Args args) {
    extern __shared__ __attribute__((aligned(16))) unsigned char lds_raw[];
    LAS unsigned char* lds = (LAS unsigned char*)lds_raw;
    typedef const Args __attribute__((address_space(4))) CArgs;
#define LA() CArgs* ap_ = (CArgs*)__builtin_amdgcn_kernarg_segment_ptr(); asm volatile("" : "+s"(ap_)); Args la; _Pragma("unroll") for (int i_ = 0; i_ < 28; ++i_) la.in[i_] = ap_->in[i_]; la.out = ap_->out; la.ws = ap_->ws; la.ph_lo = 0; la.ph_hi = 0; \
    const int tid = threadIdx.x, lane = tid & 63, wave = __builtin_amdgcn_readfirstlane(tid >> 6), bid = blockIdx.x, G = gridDim.x; (void)lane; (void)wave; (void)bid; (void)G; \
    unsigned char* const ws = la.ws; float* const OUT = la.out; float* const XC = (float*)(ws + WS_XC); const float* const MOD = (const float*)(ws + WS_MOD); \
    bf16* const H = (bf16*)(ws + WS_H); bf16* const PROJ = (bf16*)(ws + WS_PROJ); bf16* const MIX = (bf16*)(ws + WS_MIX); (void)OUT; (void)XC; (void)MOD; (void)H; (void)PROJ; (void)MIX;
    { const int tid0 = threadIdx.x; for (int u = tid0; u < (LDS_BYTES - RING_BYTES) / 4; u += NWAVES * 64) ((LAS unsigned*)(lds + RING_BYTES))[u] = 0u; }
    __syncthreads();
#if MK_MULTI
#define GRID_BAR() do { } while (0)
    const int lo = args.ph_lo, hi = args.ph_hi;
#else
    { CArgs* ap0 = (CArgs*)__builtin_amdgcn_kernarg_segment_ptr(); (void)xcd_barrier_post((unsigned*)(ap0->ws + WS_CTL) + CW_BAR, (volatile LAS unsigned*)(lds + MISC_OFF) + 8); }
#define GRID_BAR() do { CArgs* apb_ = (CArgs*)__builtin_amdgcn_kernarg_segment_ptr(); asm volatile("" : "+s"(apb_)); XcdBarrier b_; b_.bar = (unsigned*)(apb_->ws + WS_CTL) + CW_BAR; b_.x = xb_xcc_id(); \
        b_.st = (volatile LAS unsigned*)(lds + MISC_OFF) + 8; xcd_barrier(b_); } while (0)
    const int lo = args.ph_lo, hi = args.ph_hi;
#endif
#ifndef PHMASK
#define PHMASK 0xffffffffu
#endif
#define IN(k) (((PHMASK >> (k)) & 1u) && lo <= (k) && (k) < hi)
#ifndef REPEAT_MASK
#define REPEAT_MASK 0u
#endif
#define REP(k) (((REPEAT_MASK >> (k)) & 1u) ? 2 : 1)
#define SEAM(k) do { if (IN(k) && IN((k) + 1)) GRID_BAR(); } while (0)

    if (IN(0)) for (int rep_ = 0; rep_ < REP(0); ++rep_) { if (rep_) GRID_BAR(); LA(); p0_prologue(la, lds, tid, lane, wave, bid, G); } SEAM(0);
    if (IN(1)) { LA(); phase_norm<false>(la, lds, tid, lane, wave, bid, G, la.in[I_X], la.in[I_CTX], NTOK, 0, 0, nullptr, 0, nullptr); } SEAM(1);
    if (IN(2)) for (int rep_ = 0; rep_ < REP(2); ++rep_) { if (rep_) GRID_BAR(); LA(); pg8::Gemm g{H, (const bf16*)(ws + WS_W_EVIN), NTOK, EV_NP, DM}; pg8::StaticOrder S; S.init(NTOK, EV_NP, G, bid);
        pg8::EpiProj<18> E{PROJ, EV_LD, (float*)(ws + WS_G), la.in[I_EVGB]};
        pg8::gemm_phase<pg8::EpiProj<18>, pg8::StaticOrder, true, true>(lds, g, S, E); } SEAM(2);
    if (IN(3)) { LA(); phase_qknorm<8, 2, true, true>(la, lane, wave, bid, G, EV_LD, 0, 1024, la.in[I_EVQG], la.in[I_EVKG]); } SEAM(3);
    if (IN(4)) for (int rep_ = 0; rep_ < REP(4); ++rep_) { if (rep_) GRID_BAR(); LA(); phase_m3(la, lds, tid, lane, wave, bid, G); } SEAM(4);
    if (IN(5)) { LA(); phase_m4(la, tid, bid, G); } SEAM(5);
    if (IN(6)) for (int rep_ = 0; rep_ < REP(6); ++rep_) { if (rep_) GRID_BAR(); LA(); phase_m5(la, lds, tid, lane, wave, bid, G); } SEAM(6);
    if (IN(7)) for (int rep_ = 0; rep_ < REP(7); ++rep_) { if (rep_) GRID_BAR(); LA();
        const float mraw = 128.0f * wave_max(fmaxf(fabsf(la.in[I_EVQG][lane]), fabsf(la.in[I_EVQG][64 + lane]))) * wave_max(fmaxf(fabsf(la.in[I_EVKG][lane]), fabsf(la.in[I_EVKG][64 + lane])));
        const bool fixm = 2.0f * mraw * att::SCALE < 80.0f;
#define ATT0_ITEMS(FX, MR) for (int it = bid; it < 520; it += G) { __syncthreads(); const bf16 *q, *k, *v; bf16* o; int seq; \
            if (it < 512) { const int hq = it >> 6, qb = it & 63, kv = hq >> 2; q = PROJ + (size_t)qb * 256 * EV_LD + hq * 128; k = PROJ + 1024 + kv * 128; v = PROJ + 1280 + kv * 128; o = MIX + (size_t)qb * 256 * DM + hq * 128; seq = NTOK; } \
            else { const int hq = it - 512, kv = hq >> 2; const bf16* pc = PROJ + (size_t)SEQ * EV_LD; q = pc + hq * 128; k = pc + 1024 + kv * 128; v = pc + 1280 + kv * 128; o = MIX + (size_t)SEQ * DM + hq * 128; seq = CTXL; } \
            att::attn_dense_body<EV_LD, EV_LD, DM, true, 2>(q, k, v, o, seq, (char*)lds_raw, FX, MR); }
        if (fixm) {
            for (int it = bid; it < 520; it += G) { __syncthreads();
                if (it < 512) { const int gp = it >> 7, qb = it & 127, g = gp >> 1, hq = 4 * g + 2 * (gp & 1);
                    att::attn_gqa16_body<EV_LD, EV_LD, DM>(PROJ + (size_t)qb * 128 * EV_LD + hq * 128, PROJ + 1024 + g * 128, PROJ + 1280 + g * 128, MIX + (size_t)qb * 128 * DM + hq * 128, NTOK, (char*)lds_raw, mraw); }
                else { const int j = it - 512, gp = j >> 1, qb = j & 1, g = gp >> 1, hq = 4 * g + 2 * (gp & 1); const bf16* pc = PROJ + (size_t)SEQ * EV_LD;
                    att::attn_gqa16_body<EV_LD, EV_LD, DM>(pc + (size_t)qb * 128 * EV_LD + hq * 128, pc + 1024 + g * 128, pc + 1280 + g * 128, MIX + (size_t)(SEQ + qb * 128) * DM + hq * 128, CTXL, (char*)lds_raw, mraw); } }
        } else { ATT0_ITEMS(false, 0.f)
        } } SEAM(7);
    if (IN(8)) { LA(); pg8::Gemm g{MIX, (const bf16*)(ws + WS_W_EVOUT), NTOK, DM, DM}; pg8::CtxSplitOrder S{G, bid, DM / 256, 8, DM / 64};
        pg8::EpiResid E{la.in[I_X], OUT, MOD + 2 * DM, la.in[I_CTX], XC, MOD + 12288 + 2 * DM, (float*)(ws + WS_PROJ), DM / 64};
        pg8::gemm_phase<pg8::EpiResid, pg8::CtxSplitOrder, true, true>(lds, g, S, E); } SEAM(8);
    if (IN(9)) { LA(); phase_norm<false>(la, lds, tid, lane, wave, bid, G, OUT, la.in[I_CTX], NTOK, 0, 1, (const float*)(ws + WS_PROJ), 8, XC); } SEAM(9);
    if (IN(10)) for (int rep_ = 0; rep_ < REP(10); ++rep_) { if (rep_) GRID_BAR(); LA(); pg8::Gemm g{H, (const bf16*)(ws + WS_W_EVGU), NTOK, 2 * FFD, DM}; pg8::StaticOrder S; S.init(NTOK, 2 * FFD, G, bid);
        pg8::EpiSwiGlu<0> E{(bf16*)(ws + WS_BIG), FFD, 1.0f};
        pg8::gemm_phase<pg8::EpiSwiGlu<0>, pg8::StaticOrder, true, true>(lds, g, S, E); } SEAM(10);
    if (IN(11)) { LA(); pg8::Gemm g{(const bf16*)(ws + WS_BIG), (const bf16*)(ws + WS_W_EVDN), NTOK, DM, FFD}; pg8::CtxSplitOrder S{G, bid, DM / 256, 11, FFD / 64};
        pg8::EpiResid E{OUT, OUT, MOD + 5 * DM, XC, XC, MOD + 12288 + 5 * DM, (float*)(ws + WS_PROJ + 32 * MiB), FFD / 64};
        pg8::gemm_phase<pg8::EpiResid, pg8::CtxSplitOrder, true, true>(lds, g, S, E); } SEAM(11);
    if (IN(12)) { LA(); phase_norm<false>(la, lds, tid, lane, wave, bid, G, OUT, XC, NTOK, 1, 0, (const float*)(ws + WS_PROJ + 32 * MiB), 11, nullptr); } SEAM(12);
    if (IN(13)) { LA(); pg8::Gemm g{H, (const bf16*)(ws + WS_W_ODIN), NTOK, OD_LD, DM}; pg8::OdInOrder S{G, bid};
        pg8::EpiProj<-1> E{PROJ, OD_LD, nullptr, nullptr};
        pg8::gemm_phase<pg8::EpiProj<-1>, pg8::OdInOrder, true, true>(lds, g, S, E); } SEAM(13);
    if (IN(14)) { LA(); phase_qknorm<16, 16, false, false>(la, lane, wave, bid, G, OD_LD, 0, 2048, la.in[I_ODQG], la.in[I_ODKG]); } SEAM(14);
#define P15_FIXM() const float mraw = 128.0f * wave_max(fmaxf(fabsf(la.in[I_ODQG][lane]), fabsf(la.in[I_ODQG][64 + lane]))) * wave_max(fmaxf(fabsf(la.in[I_ODKG][lane]), fabsf(la.in[I_ODKG][64 + lane]))); \
        const bool fixm = 2.0f * mraw * att::SCALE < 80.0f; float* O1 = (float*)(ws + WS_BIG);
    if (IN(15)) for (int rep_ = 0; rep_ < REP(15); ++rep_) { if (rep_) GRID_BAR(); LA(); P15_FIXM();
        if (fixm) {
            const float lam_init = 0.8f - 0.6f * expf(-0.3f);
            const float d1 = wave_sum(la.in[I_LQ1][lane] * la.in[I_LK1][lane] + la.in[I_LQ1][64 + lane] * la.in[I_LK1][64 + lane]);
            const float d2 = wave_sum(la.in[I_LQ2][lane] * la.in[I_LK2][lane] + la.in[I_LQ2][64 + lane] * la.in[I_LK2][64 + lane]);
            const float lam = expf(d1) - expf(d2) + lam_init;
            for (int it = bid; it < 1024; it += G) { __syncthreads(); const int h = it >> 7, qb = it & 127;
                att::attn_diff16_body<OD_LD, OD_LD, OD_LD, 4096, DM>(PROJ + (size_t)qb * 128 * OD_LD + h * 256, PROJ + 2048 + h * 256, PROJ + 4096 + h * 256,
                                                                O1 + (size_t)qb * 128 * 4096 + h * 512, MIX + (size_t)qb * 128 * DM + h * 256, NTOK, (char*)lds_raw, mraw, lam, 1.0f - lam_init, la.in[I_ODSG]); } }
        else { for (int it = bid; it < 2048; it += G) { __syncthreads(); const int vh = it >> 6, qb = it & 63, h = vh >> 2, r = (vh >> 1) & 1, c = vh & 1;
            att::attn_dense_body<OD_LD, OD_LD, 4096, false, 1>(PROJ + (size_t)qb * 256 * OD_LD + h * 256 + r * 128, PROJ + 2048 + h * 256 + r * 128, PROJ + 4096 + h * 256 + c * 128,
                                                                O1 + (size_t)qb * 256 * 4096 + (h * 2 + r) * 256 + c * 128, NTOK, (char*)lds_raw, false, 0.f); } } }
    SEAM(15);
    if (IN(16)) { LA(); P15_FIXM(); (void)O1; if (!fixm) phase_combine(la, lane, wave, bid, G); } SEAM(16);
    if (IN(17)) { LA(); pg8::Gemm g{MIX, (const bf16*)(ws + WS_W_ODOUT), SEQ, DM, DM}; pg8::StaticOrder S; S.init(SEQ, DM, G, bid);
        pg8::EpiResid E{OUT, OUT, MOD + 2 * 12288 + 2 * DM, XC, XC, MOD + 3 * 12288 + 2 * DM, nullptr, DM / 64};
        pg8::gemm_phase<pg8::EpiResid, pg8::StaticOrder, true, true>(lds, g, S, E); } SEAM(17);
    if (IN(18)) { LA(); phase_norm<true>(la, lds, tid, lane, wave, bid, G, OUT, XC, SEQ, 1, 1, nullptr, 0, nullptr); } SEAM(18);
    if (IN(19)) { LA(); phase_gather(la, lane, wave, bid, G); } SEAM(19);
    if (IN(20)) for (int rep_ = 0; rep_ < REP(20); ++rep_) { if (rep_) GRID_BAR(); LA(); pg8::Gemm g{PROJ, (const bf16*)(ws + WS_W_EXGU), MAXROWS, 8 * 2 * FFE, DM / 2}; pg8::GroupedOrder S; S.init((const unsigned*)(ws + WS_CTL) + CW_CNT, 2 * FFE / 256, G, bid);
        pg8::EpiSwiGlu<2 * FFE / 256, true> E{(bf16*)(ws + WS_BIG), FFE, 1.0f / EXGU_SCALE};
        pg8::gemm_phase<pg8::EpiSwiGlu<2 * FFE / 256, true>, pg8::GroupedOrder, true, true, true>(lds, g, S, E); } SEAM(20);
    if (IN(21)) { LA(); pg8::Gemm g{(const bf16*)(ws + WS_BIG), (const bf16*)(ws + WS_W_EXDN), MAXROWS, 8 * DM, FFE / 2}; pg8::GroupedOrder S; S.init((const unsigned*)(ws + WS_CTL) + CW_CNT, DM / 256, G, bid, FFE / 128);
        pg8::EpiMoeDown E{PROJ, (float*)(ws + WS_H), S.pm_split, S.nM - S.pm_split, FFE / 128, 1.0f / EXDN_SCALE};
        pg8::gemm_phase<pg8::EpiMoeDown, pg8::GroupedOrder, true, true, true>(lds, g, S, E); } SEAM(21);
    if (IN(22)) { LA(); phase_moe_combine(la, lane, wave, bid, G); }
#undef IN
#undef SEAM
}


extern "C" void kernel_launch(void* const* d_in, const int* in_sizes, int n_in, void* d_out, int out_size, void* d_ws, size_t ws_size, hipStream_t stream) {
    static int grid = 0;
    if (grid == 0) {
        if (n_in != 28 || out_size != SEQ * DM || ws_size < WS_END) { fprintf(stderr, "kernel_launch: unexpected shapes: n_in %d out %d ws %zu (need %zu)\n", n_in, out_size, ws_size, (size_t)WS_END); grid = -1; return; }
        int dev = 0, cus = 0, per_cu = 0;
        if (hipGetDevice(&dev) != hipSuccess || hipDeviceGetAttribute(&cus, hipDeviceAttributeMultiprocessorCount, dev) != hipSuccess) { grid = -1; return; }
        if (hipFuncSetAttribute((const void*)mega_fwd, hipFuncAttributeMaxDynamicSharedMemorySize, LDS_BYTES) != hipSuccess) { fprintf(stderr, "kernel_launch: hipFuncSetAttribute failed\n"); grid = -1; return; }
        if (hipOccupancyMaxActiveBlocksPerMultiprocessor(&per_cu, (const void*)mega_fwd, NWAVES * 64, LDS_BYTES) != hipSuccess || per_cu < 1) { fprintf(stderr, "kernel_launch: occupancy query reports %d\n", per_cu); }
        (void)hipGetLastError();
        grid = cus;
    }
    if (grid < 0) return;
    (void)hipMemsetAsync((char*)d_ws + WS_CTL, 0, CTL_ZERO_BYTES, stream);
    Args a{};
    for (int i = 0; i < 28; ++i) a.in[i] = (const float*)d_in[i];
    a.out = (float*)d_out; a.ws = (unsigned char*)d_ws;
#if MK_MULTI
    for (int k = 0; k < NPH; ++k) { a.ph_lo = k; a.ph_hi = k + 1; hipLaunchKernelGGL(mega_fwd, dim3(grid), dim3(NWAVES * 64), LDS_BYTES, stream, a); }
#else
    a.ph_lo = 0; a.ph_hi = NPH; hipLaunchKernelGGL(mega_fwd, dim3(grid), dim3(NWAVES * 64), LDS_BYTES, stream, a);
#endif
    const hipError_t le = hipPeekAtLastError();
    if (le != hipSuccess) fprintf(stderr, "kernel_launch: launch failed: %s\n", hipGetErrorName(le));
}
```
